# Optimizing an MI355X kernel written in HIP

```python
import jax, jax.numpy as jnp
from jax import lax
import numpy as np

D_MODEL = 2048
BATCH = 2
SEQ = 4096
DEPTH = 2

CONV_CH = 1024
CONV_GROUPS = 8
CONV_K = 31
MLA_HEADS = 8
QK_NOPE = 128
QK_ROPE = 64
V_HEAD = 128
Q_RANK = 512
KV_RANK = 512
ROPE_BASE = 10000.0
Q_BLOCK = 128
MLA_WIDTH = MLA_HEADS * V_HEAD
HGRN_HEADS = 16
HGRN_EXPAND = 128
HGRN_FDIM = HGRN_HEADS * HGRN_EXPAND
HGRN_HEAD_V = D_MODEL // HGRN_HEADS
HGRN_CHUNK = 64
EPS = 1e-6

N_EVEN = (DEPTH + 1) // 2
N_ODD = DEPTH // 2
EVEN_MIX = CONV_CH + MLA_WIDTH
EVEN_IN = 3 * CONV_CH + Q_RANK + KV_RANK + QK_ROPE + MLA_WIDTH
ODD_IN = 2 * HGRN_FDIM + 2 * D_MODEL

kernel_name = "hybrid_conv_mla_hgrn2_gated"


def _split(p, sizes):
    out, off = [], 0
    for s in sizes:
        out.append(p[..., off:off + s])
        off += s
    return out


def rmsnorm(x, g):
    xf = x.astype(jnp.float32)
    y = xf * lax.rsqrt(jnp.mean(xf * xf, axis=-1, keepdims=True) + EPS)
    return (y * g.astype(jnp.float32)).astype(x.dtype)


def rope_tables(seq):
    inv_freq = 1.0 / (ROPE_BASE ** (jnp.arange(0, QK_ROPE, 2, dtype=jnp.float32) / QK_ROPE))
    ang = jnp.arange(seq, dtype=jnp.float32)[:, None] * inv_freq[None, :]
    return jnp.cos(ang), jnp.sin(ang)


def apply_rope(x, cos, sin):
    x1, x2 = jnp.split(x.astype(jnp.float32), 2, axis=-1)
    c = cos[None, :, None, :]
    s = sin[None, :, None, :]
    return jnp.concatenate([x1 * c - x2 * s, x1 * s + x2 * c], axis=-1).astype(x.dtype)


def conformer_conv(v, g_glu, z, w_dw, b_dw, ln_g, ln_b):
    u = v * jax.nn.sigmoid(g_glu)
    u = jnp.pad(u, ((0, 0), (CONV_K - 1, 0), (0, 0)))
    y = lax.conv_general_dilated(u, w_dw[:, None, :].astype(u.dtype), window_strides=(1,),
                                 padding='VALID', dimension_numbers=('NWC', 'WIO', 'NWC'),
                                 feature_group_count=CONV_CH) + b_dw
    B, S, C = y.shape
    yf = y.astype(jnp.float32).reshape(B, S, CONV_GROUPS, C // CONV_GROUPS)
    mu = jnp.mean(yf, axis=-1, keepdims=True)
    var = jnp.mean(jnp.square(yf - mu), axis=-1, keepdims=True)
    yf = ((yf - mu) * lax.rsqrt(var + EPS)).reshape(B, S, C)
    y = (yf * ln_g.astype(jnp.float32) + ln_b.astype(jnp.float32)).astype(v.dtype)
    return jax.nn.silu(y) * jax.nn.silu(z)


def mla(c_q, c_kv, k_pe, q_norm_g, w_uq, kv_norm_g, w_ukv, cos, sin):
    B, S, _ = c_q.shape
    q = jnp.einsum('bsr,rhd->bshd', rmsnorm(c_q, q_norm_g), w_uq)
    q_nope, q_pe = q[..., :QK_NOPE], apply_rope(q[..., QK_NOPE:], cos, sin)
    kv = jnp.einsum('bsr,rhd->bshd', rmsnorm(c_kv, kv_norm_g), w_ukv)
    k_nope, v = kv[..., :QK_NOPE], kv[..., QK_NOPE:]
    k_pe = apply_rope(k_pe[:, :, None, :], cos, sin)[:, :, 0, :]
    scale = (QK_NOPE + QK_ROPE) ** -0.5
    n_blk = S // Q_BLOCK
    qn_b = q_nope.reshape(B, n_blk, Q_BLOCK, MLA_HEADS, QK_NOPE).transpose(1, 0, 2, 3, 4)
    qp_b = q_pe.reshape(B, n_blk, Q_BLOCK, MLA_HEADS, QK_ROPE).transpose(1, 0, 2, 3, 4)
    kpos = jnp.arange(S)

    def block(args):
        qn, qp, i = args
        s = (jnp.einsum('bqhd,bkhd->bhqk', qn, k_nope) +
             jnp.einsum('bqhr,bkr->bhqk', qp, k_pe)).astype(jnp.float32) * scale
        qpos = i * Q_BLOCK + jnp.arange(Q_BLOCK)
        mask = kpos[None, :] <= qpos[:, None]
        s = jnp.where(mask[None, None], s, -jnp.inf)
        p = jax.nn.softmax(s, axis=-1).astype(v.dtype)
        return jnp.einsum('bhqk,bkhd->bqhd', p, v)

    o = lax.map(block, (qn_b, qp_b, jnp.arange(n_blk)))
    return o.transpose(1, 0, 2, 3, 4).reshape(B, S, MLA_WIDTH)


def hgrn2(q, f_raw, i_val, lb, norm_g):
    B, S, _ = q.shape
    H, K, V, C = HGRN_HEADS, HGRN_EXPAND, HGRN_HEAD_V, HGRN_CHUNK
    nC = S // C
    logf = jnp.logaddexp(jnp.log(lb), jnp.log1p(-lb) + jax.nn.log_sigmoid(f_raw.astype(jnp.float32)))
    k = -jnp.expm1(logf)

    def chunks(t, d):
        return t.astype(jnp.float32).reshape(B, nC, C, H, d).transpose(1, 0, 3, 2, 4)

    qc, kc, gc, vc = chunks(q, K), chunks(k, K), chunks(logf, K), chunks(i_val, V)
    tri = jnp.tril(jnp.ones((C, C), dtype=bool))

    def step(state, inp):
        qq, kk, gg, vv = inp
        b = jnp.cumsum(gg, axis=2)
        diff = b[:, :, :, None, :] - b[:, :, None, :, :]
        decay = jnp.exp(jnp.where(tri[None, None, :, :, None], diff, -jnp.inf))
        A = jnp.einsum('bhtk,bhsk,bhtsk->bhts', qq, kk, decay)
        o = (jnp.einsum('bhts,bhsv->bhtv', A, vv) +
             jnp.einsum('bhtk,bhkv->bhtv', qq * jnp.exp(b), state))
        b_last = b[:, :, -1:, :]
        new_state = (jnp.exp(b_last)[:, :, 0, :, None] * state +
                     jnp.einsum('bhsk,bhsv->bhkv', kk * jnp.exp(b_last - b), vv))
        return new_state, o

    state0 = jnp.zeros((B, H, K, V), jnp.float32)
    _, o = lax.scan(step, state0, (qc, kc, gc, vc))
    o = o.transpose(1, 0, 3, 2, 4).reshape(B, S, H, V).astype(q.dtype)
    return rmsnorm(o, norm_g).reshape(B, S, H * V)


def setup_inputs(seed: int = 0) -> dict:
    key = jax.random.key(seed)
    ks = jax.random.split(key, 18)

    def nrm(k, shape, scale):
        return jax.random.normal(k, shape, jnp.float32) * scale

    def gain(k, shape):
        return 1.0 + 0.02 * jax.random.normal(k, shape, jnp.float32)

    return {
        "x": nrm(ks[0], (BATCH, SEQ, D_MODEL), 1.0),
        "ev_norm_g": gain(ks[1], (N_EVEN, D_MODEL)),
        "ev_w_in": nrm(ks[2], (N_EVEN, D_MODEL, EVEN_IN), D_MODEL ** -0.5),
        "conv_w": nrm(ks[3], (N_EVEN, CONV_K, CONV_CH), CONV_K ** -0.5),
        "conv_b": nrm(ks[4], (N_EVEN, CONV_CH), 0.02),
        "conv_ln_g": gain(ks[5], (N_EVEN, CONV_CH)),
        "conv_ln_b": nrm(ks[6], (N_EVEN, CONV_CH), 0.02),
        "mla_q_norm_g": gain(ks[7], (N_EVEN, Q_RANK)),
        "mla_w_uq": nrm(ks[8], (N_EVEN, Q_RANK, MLA_HEADS, QK_NOPE + QK_ROPE), Q_RANK ** -0.5),
        "mla_kv_norm_g": gain(ks[9], (N_EVEN, KV_RANK)),
        "mla_w_ukv": nrm(ks[10], (N_EVEN, KV_RANK, MLA_HEADS, QK_NOPE + V_HEAD), KV_RANK ** -0.5),
        "ev_w_out": nrm(ks[11], (N_EVEN, EVEN_MIX, D_MODEL), EVEN_MIX ** -0.5),
        "od_norm_g": gain(ks[12], (N_ODD, D_MODEL)),
        "od_w_in": nrm(ks[13], (N_ODD, D_MODEL, ODD_IN), D_MODEL ** -0.5),
        "hgrn_lb_logits": nrm(ks[14], (DEPTH, HGRN_FDIM), 0.5),
        "hgrn_norm_g": gain(ks[15], (N_ODD, HGRN_HEAD_V)),
        "od_w_out": nrm(ks[16], (N_ODD, D_MODEL, D_MODEL), D_MODEL ** -0.5),
        "final_norm_g": gain(ks[17], (D_MODEL,)),
    }


def reference(x, ev_norm_g, ev_w_in, conv_w, conv_b, conv_ln_g, conv_ln_b, mla_q_norm_g, mla_w_uq,
              mla_kv_norm_g, mla_w_ukv, ev_w_out, od_norm_g, od_w_in, hgrn_lb_logits, hgrn_norm_g,
              od_w_out, final_norm_g):
    S = x.shape[1]
    cos, sin = rope_tables(S)
    lb_all = jnp.cumsum(jax.nn.softmax(hgrn_lb_logits.astype(jnp.float32), axis=0), axis=0)
    lb_all = lb_all - lb_all[0:1]
    for l in range(DEPTH):
        if l % 2 == 0:
            j = l // 2
            h = rmsnorm(x, ev_norm_g[j])
            p = h @ ev_w_in[j]
            a_v, a_g, a_z, c_q, c_kv, k_pe, b_z = _split(
                p, [CONV_CH, CONV_CH, CONV_CH, Q_RANK, KV_RANK, QK_ROPE, MLA_WIDTH])
            a_out = conformer_conv(a_v, a_g, a_z, conv_w[j], conv_b[j], conv_ln_g[j], conv_ln_b[j])
            b_out = mla(c_q, c_kv, k_pe, mla_q_norm_g[j], mla_w_uq[j], mla_kv_norm_g[j],
                        mla_w_ukv[j], cos, sin) * jax.nn.silu(b_z)
            x = x + jnp.concatenate([a_out, b_out], axis=-1) @ ev_w_out[j]
        else:
            j = l // 2
            h = rmsnorm(x, od_norm_g[j])
            p = h @ od_w_in[j]
            q, f_raw, i_val, g = _split(p, [HGRN_FDIM, HGRN_FDIM, D_MODEL, D_MODEL])
            o = hgrn2(q, f_raw, i_val, lb_all[l], hgrn_norm_g[j]) * jax.nn.silu(g)
            x = x + o @ od_w_out[j]
    return rmsnorm(x, final_norm_g)
```

```cpp
#include <hip/hip_runtime.h>
#include <hip/hip_cooperative_groups.h>
#include <cstdio>
#include <cstdint>
namespace cg = cooperative_groups;

#define LAS __attribute__((address_space(3)))
typedef unsigned short bf16_t;
typedef short bf16x8 __attribute__((ext_vector_type(8)));
typedef short s16x4 __attribute__((ext_vector_type(4)));
typedef float f32x4 __attribute__((ext_vector_type(4)));
typedef float f32x2 __attribute__((ext_vector_type(2)));
typedef float f32x16 __attribute__((ext_vector_type(16)));
typedef unsigned u32x4 __attribute__((ext_vector_type(4)));
typedef unsigned u32x2 __attribute__((ext_vector_type(2)));
typedef __bf16 bf2_t __attribute__((ext_vector_type(2)));

#define DI __device__ __forceinline__
typedef _Float16 h2_t __attribute__((ext_vector_type(2)));
DI unsigned pkh2(float lo, float hi) { f32x2 v = {lo, hi}; h2_t b = __builtin_convertvector(v, h2_t); return __builtin_bit_cast(unsigned, b); }
DI float h2f(unsigned short u) { return (float)__builtin_bit_cast(_Float16, u); }
DI unsigned pk2(float lo, float hi) { f32x2 v = {lo, hi}; bf2_t b = __builtin_convertvector(v, bf2_t); return __builtin_bit_cast(unsigned, b); }
DI float bf2f(unsigned short u) { return __builtin_bit_cast(float, (unsigned)u << 16); }
DI float bflo(unsigned u) { return __builtin_bit_cast(float, u << 16); }
DI float bfhi(unsigned u) { return __builtin_bit_cast(float, u & 0xffff0000u); }
DI float fexp2(float x) { return __builtin_amdgcn_exp2f(x); }
DI float fexp(float x) { return __builtin_amdgcn_exp2f(x * 1.4426950408889634f); }
DI float frcp(float x) { return __builtin_amdgcn_rcpf(x); }
DI float flog(float x) { return __builtin_amdgcn_logf(x) * 0.6931471805599453f; }
DI float sigmoidf_(float x) { return frcp(1.f + fexp(-x)); }
DI float siluf_(float x) { return x * frcp(1.f + fexp(-x)); }
DI float wave_sum(float v) {
#pragma unroll
    for (int o = 1; o < 64; o <<= 1) v += __shfl_xor(v, o);
    return v;
}

constexpr int T_ = 8192, SEQ = 4096, DM = 2048;
constexpr int EVIN = 5184, EVIN_PAD = 5376, LDP = 5184;
constexpr float EPS_ = 1e-6f;
constexpr float QSCALE = 0.07216878364870322f * 1.4426950408889634f;

constexpr size_t MiB = 1048576;
constexpr size_t WS_RS0 = 0;
constexpr size_t WS_LB = 64 * 1024;
constexpr size_t WS_SSQ = 128 * 1024;
constexpr size_t WS_BAR = 768 * 1024;
constexpr size_t WS_PCNT = WS_BAR + 2 * 3456 * 4;
constexpr size_t WS_SSQ1 = 1 * MiB;
constexpr size_t WS_ROPEC = 2 * MiB;
constexpr size_t WS_ROPES = 2 * MiB + 512 * 1024;
constexpr size_t WS_DEC = 3 * MiB;
constexpr size_t WS_WEVIN = 4 * MiB;
constexpr size_t WS_WUQ = 25 * MiB;
constexpr size_t WS_WUKV = WS_WUQ + 3 * MiB / 2;
constexpr size_t WS_WEVOUT = WS_WUKV + 2 * MiB;
constexpr size_t WS_WODIN = WS_WEVOUT + 8 * MiB;
constexpr size_t WS_WODOUT = WS_WODIN + 32 * MiB;
constexpr size_t WS_XB = WS_WODOUT + 8 * MiB;
constexpr size_t WS_MIX = WS_XB;
constexpr size_t WS_PBUF = WS_XB + 32 * MiB;
constexpr size_t WS_QH = WS_PBUF + 81 * MiB;
constexpr size_t WS_KN = WS_QH + 24 * MiB;
constexpr size_t WS_VT = WS_KN + 16 * MiB;
constexpr size_t WS_KPE = WS_VT + 16 * MiB;
constexpr size_t WS_END1 = WS_KPE + 1 * MiB;
constexpr size_t WS_X1B = WS_PBUF;
constexpr size_t WS_Q2 = WS_XB;
constexpr size_t WS_LOGF = WS_PBUF + 32 * MiB;
constexpr size_t WS_IV = WS_LOGF + 64 * MiB;
constexpr size_t WS_G2 = 4 * MiB;
constexpr size_t WS_DS0 = WS_WODIN;
constexpr size_t WS_DS1 = WS_X1B;
constexpr size_t WS_DUMMY = 237 * MiB;
constexpr size_t WS_NEED = 253 * MiB;
static_assert(WS_IV + 32 * MiB <= WS_NEED && WS_END1 <= WS_NEED, "ws map");
static_assert(WS_G2 + 32 * MiB <= WS_WODIN, "G2 overlaps ODIN");

namespace pg8 {
constexpr int BM = 256, BK = 64, HALF = 128, HTB = HALF * BK * 2, STAGE_BYTES = 8 * HTB, NXCD = 8, WGM = 8;
__host__ __device__ __forceinline__ int lds_byte(int r, int c) { const int st = (r >> 4) * 2 + (c >> 5), rr = r & 15, cc = c & 31, ob = rr * 64 + cc * 2; return st * 1024 + (ob ^ (((ob >> 9) & 1) << 5)); }
__host__ __device__ __forceinline__ void stage_rc(int b, int& R, int& C) { const int st = b / 1024, sb = b % 1024, swz = sb ^ (((sb >> 9) & 1) << 5); R = (st >> 1) * 16 + swz / 64; C = (st & 1) * 32 + (swz % 64) / 2; }
__host__ __device__ __forceinline__ int perm32(int rho) { const int n = rho >> 4, i = rho & 15; return 8 * (i >> 2) + 4 * n + (i & 3); }
struct Unit { int pm, pn; };
struct Gemm { const bf16_t* A; const bf16_t* Bt; int M, N, K, lda, ldb; };
struct StaticOrder {
    int nM, nN, nwg, G, c;
    __host__ __device__ void init(int M, int N, int G_, int c_) { nM = M / BM; nN = N / BM; nwg = nM * nN; G = G_; c = c_; }
    __host__ __device__ bool next(int i, Unit& u) const {
        const long L = (long)i * G + c; if (L >= nwg) return false;
        int wgid = (int)L; { const int q = nwg / NXCD, r = nwg % NXCD, xcd = wgid % NXCD, off = wgid / NXCD; wgid = (xcd < r ? xcd * (q + 1) : r * (q + 1) + (xcd - r) * q) + off; }
        const int nig = WGM * nN, gid = wgid / nig, fm = gid * WGM, gsz = (nM - fm) < WGM ? (nM - fm) : WGM;
        u.pm = fm + ((wgid % nig) % gsz); u.pn = (wgid % nig) / gsz; return true;
    }
};

template <class Epi, class Sched>
__device__ __forceinline__ void gemm_phase(LAS unsigned char* lds, const Gemm g, const Sched& S, const Epi& E) {
    const int tid = threadIdx.x, wid = __builtin_amdgcn_readfirstlane(tid >> 6), lane = tid & 63, wr = wid >> 2, wc = wid & 3, fr = lane & 15, fq = lane >> 4;
    const int K = g.K, nt = K / BK;
    unsigned voffA[2], voffB[2];
#pragma unroll
    for (int i = 0; i < 2; ++i) { int R, C; stage_rc(tid * 16 + i * 8192, R, C); const int Rb = Epi::PERM ? ((R & ~31) + perm32(R & 31)) : R;
        voffA[i] = (unsigned)(R * g.lda + C) * 2u; voffB[i] = (unsigned)(Rb * g.ldb + C) * 2u; }
    const size_t kstep = (size_t)(BK * 2);
    const size_t hsA = (size_t)HALF * g.lda * 2, hsB = (size_t)HALF * g.ldb * 2;
    const size_t tsA = 2 * hsA, tsB = 2 * hsB;
    const unsigned ldsw = (unsigned)wid * 1024u;
    const int aoff = lds_byte(wr * 64 + fr, fq * 8), boff = lds_byte(wc * 32 + fr, fq * 8);
#define PG8_SA(b, h) (((b) * 2 + (h)) * HTB)
#define PG8_SB(b, h) ((4 + (b) * 2 + (h)) * HTB)
#define PG8_STAGE(bufoff, gbase, voff) do { _Pragma("unroll") for (int _i = 0; _i < 2; ++_i) \
        __builtin_amdgcn_global_load_lds((const unsigned*)((const char*)(gbase) + (voff)[_i]), (LAS unsigned*)(lds + (bufoff) + ldsw + _i * 8192), 16, 0, 0); } while (0)
#define PG8_LDA(dst, b, h) do { _Pragma("unroll") for (int m = 0; m < 4; ++m) _Pragma("unroll") for (int k = 0; k < 2; ++k) dst[m][k] = *(const LAS bf16x8*)(lds + PG8_SA(b, h) + aoff + m * 2048 + k * 1024); } while (0)
#define PG8_LDB(dst, b, h) do { _Pragma("unroll") for (int n = 0; n < 2; ++n) _Pragma("unroll") for (int k = 0; k < 2; ++k) dst[n][k] = *(const LAS bf16x8*)(lds + PG8_SB(b, h) + boff + n * 2048 + k * 1024); } while (0)
#define PG8_MMA(ai, bj, At, Bt) do { __builtin_amdgcn_s_setprio(1); _Pragma("unroll") for (int m = 0; m < 4; ++m) _Pragma("unroll") for (int n = 0; n < 2; ++n) _Pragma("unroll") for (int k = 0; k < 2; ++k) \
        acc[ai][bj][m][n] = __builtin_amdgcn_mfma_f32_16x16x32_bf16(Bt[n][k], At[m][k], acc[ai][bj][m][n], 0, 0, 0); __builtin_amdgcn_s_setprio(0); } while (0)
#define PG8_WAIT_V(n) asm volatile("s_waitcnt vmcnt(" #n ")" ::: "memory")
#define PG8_WAIT_L(n) asm volatile("s_waitcnt lgkmcnt(" #n ")" ::: "memory")
#define PG8_BAR __builtin_amdgcn_s_barrier()
#define PG8_SCHED __builtin_amdgcn_sched_barrier(0)
    Unit cur, nxt; int ui = 0;
    if (!S.next(0, cur)) return;
    f32x4 acc[2][2][4][2];
#pragma unroll
    for (int a = 0; a < 2; ++a)
#pragma unroll
        for (int b = 0; b < 2; ++b)
#pragma unroll
            for (int m = 0; m < 4; ++m)
#pragma unroll
                for (int n = 0; n < 2; ++n) acc[a][b][m][n] = (f32x4){0.f, 0.f, 0.f, 0.f};
    bf16x8 At[4][2], B0[2][2], B1[2][2];
    const char* cA = (const char*)g.A + (size_t)cur.pm * tsA; const char* cB = (const char*)g.Bt + (size_t)cur.pn * tsB;
    PG8_STAGE(PG8_SB(0, 0), cB, voffB); PG8_STAGE(PG8_SB(0, 1), cB + hsB, voffB); PG8_STAGE(PG8_SA(0, 0), cA, voffA); PG8_STAGE(PG8_SA(0, 1), cA + hsA, voffA);
    if (wr == 1) PG8_BAR;
    PG8_WAIT_V(2); PG8_BAR;
    PG8_STAGE(PG8_SB(1, 0), cB + kstep, voffB); PG8_STAGE(PG8_SA(1, 0), cA + kstep, voffA); PG8_STAGE(PG8_SB(1, 1), cB + hsB + kstep, voffB);
    PG8_WAIT_V(6); PG8_BAR;
    for (;;) {
        float pre[8];
        if constexpr (Epi::PRE) E.pre_load(cur, wr, fr, pre);
        const bool has_next = S.next(ui + 1, nxt);
        const char* nA = has_next ? (const char*)g.A + (size_t)nxt.pm * tsA : cA; const char* nB = has_next ? (const char*)g.Bt + (size_t)nxt.pn * tsB : cB;
        for (int t = 0; t < nt; t += 2) {
            const bool last = (t == nt - 2);
            const char* a1 = cA + (size_t)(t + 1) * kstep;
            const char* a2 = last ? nA : cA + (size_t)(t + 2) * kstep; const char* b2 = last ? nB : cB + (size_t)(t + 2) * kstep;
            const char* a3 = a2 + kstep; const char* b3 = b2 + kstep;
            PG8_LDB(B0, 0, 0); PG8_LDB(B1, 0, 1); PG8_SCHED; PG8_LDA(At, 0, 0); PG8_STAGE(PG8_SA(1, 1), a1 + hsA, voffA);
            PG8_WAIT_V(8); PG8_WAIT_L(0); PG8_BAR; PG8_MMA(0, 0, At, B0); PG8_MMA(0, 1, At, B1); PG8_BAR; PG8_SCHED;
            PG8_LDA(At, 0, 1); PG8_STAGE(PG8_SB(0, 0), b2, voffB); PG8_STAGE(PG8_SB(0, 1), b2 + hsB, voffB); PG8_STAGE(PG8_SA(0, 0), a2, voffA);
            PG8_WAIT_V(8); PG8_WAIT_L(0); PG8_BAR; PG8_MMA(1, 0, At, B0); PG8_MMA(1, 1, At, B1); PG8_BAR; PG8_SCHED;
            PG8_LDB(B0, 1, 0); PG8_LDB(B1, 1, 1); PG8_SCHED; PG8_LDA(At, 1, 0); PG8_STAGE(PG8_SA(0, 1), a2 + hsA, voffA);
            PG8_WAIT_V(8); PG8_WAIT_L(0); PG8_BAR; PG8_MMA(0, 0, At, B0); PG8_MMA(0, 1, At, B1); PG8_BAR; PG8_SCHED;
            PG8_LDA(At, 1, 1); PG8_STAGE(PG8_SB(1, 0), b3, voffB); PG8_STAGE(PG8_SB(1, 1), b3 + hsB, voffB); PG8_STAGE(PG8_SA(1, 0), a3, voffA);
            PG8_WAIT_V(8); PG8_WAIT_L(0); PG8_BAR; PG8_MMA(1, 0, At, B0); PG8_MMA(1, 1, At, B1); PG8_BAR; PG8_SCHED;
        }
        if (wr == 0) PG8_BAR;
        if constexpr (Epi::PRE) E.with_pre(acc, cur, wr, wc, fr, fq, pre);
        else if constexpr (!Epi::AFTER_DRAIN) E(acc, cur, wr, wc, fr, fq);
        if (!has_next) break;
#pragma unroll
        for (int a = 0; a < 2; ++a)
#pragma unroll
            for (int b = 0; b < 2; ++b)
#pragma unroll
                for (int m = 0; m < 4; ++m)
#pragma unroll
                    for (int n = 0; n < 2; ++n) acc[a][b][m][n] = (f32x4){0.f, 0.f, 0.f, 0.f};
        cur = nxt; cA = nA; cB = nB; ++ui;
        if (wr == 1) PG8_BAR;
    }
    PG8_WAIT_V(0);
    PG8_BAR;
    if constexpr (Epi::AFTER_DRAIN) E.fused(acc, cur, wr, wc, fr, fq, lds, wid, lane);
#undef PG8_SA
#undef PG8_SB
#undef PG8_STAGE
#undef PG8_LDA
#undef PG8_LDB
#undef PG8_MMA
#undef PG8_WAIT_V
#undef PG8_WAIT_L
#undef PG8_BAR
#undef PG8_SCHED
}
}
using pg8::Unit;

DI u32x4 pack8(const f32x4 a, const f32x4 b) { u32x4 w; w.x = pk2(a[0], a[1]); w.y = pk2(a[2], a[3]); w.z = pk2(b[0], b[1]); w.w = pk2(b[2], b[3]); return w; }
DI u32x2 pack4(const f32x4 a) { u32x2 w; w.x = pk2(a[0], a[1]); w.y = pk2(a[2], a[3]); return w; }
DI float dot4(const f32x4 a) { return (a[0] * a[0] + a[1] * a[1]) + (a[2] * a[2] + a[3] * a[3]); }

#define EPI_FENCE() asm volatile("" ::: "memory")
struct EpiP1 {
    static constexpr bool PRE = true;
    DI void pre_load(const Unit& u, int wr, int fr, float (&pre)[8]) const {
        const int rbase = u.pm * 256 + wr * 64 + fr;
#pragma unroll
        for (int i = 0; i < 8; ++i) pre[i] = rs0[rbase + (i >> 2) * 128 + (i & 3) * 16];
    }
    static constexpr bool AFTER_DRAIN = false;
    static constexpr bool PERM = true;
    bf16_t* P; const float* rs0; bf16_t* kpe; float* ssq; const float* rc; const float* rsn;
    DI void with_pre(const f32x4 (&acc)[2][2][4][2], const Unit& u, int wr, int wc, int fr, int fq, const float (&rsv)[8]) const {
        const int colt = u.pn * 256;
        const bool do_ssq = (u.pn >= 12 && u.pn < 16);
        const int rbase = u.pm * 256 + wr * 64 + fr;
        const bool rope_tile = (u.pn == 16);
        const int c00 = colt + wc * 32 + 8 * fq;
        const bool rope_lane = rope_tile && (c00 < 4160);
        f32x4 cv[8], sv[8];
        if (rope_lane) {
            const int i0 = ((c00 - 4096) >> 3) * 4;
#pragma unroll
            for (int i = 0; i < 8; ++i) { const int pos = (rbase + (i >> 2) * 128 + (i & 3) * 16) & (SEQ - 1); cv[i] = *(const f32x4*)(rc + pos * 32 + i0); sv[i] = *(const f32x4*)(rsn + pos * 32 + i0); }
        }
        EPI_FENCE();
#pragma unroll
        for (int ai = 0; ai < 2; ++ai)
#pragma unroll
            for (int m = 0; m < 4; ++m) {
                const int r = rbase + ai * 128 + m * 16;
                const float rs = rsv[ai * 4 + m];
                float ss = 0.f;
#pragma unroll
                for (int bj = 0; bj < 2; ++bj) {
                    const int c0 = c00 + bj * 128;
                    const f32x4 v0 = acc[ai][bj][m][0] * rs, v1 = acc[ai][bj][m][1] * rs;
                    if (bj == 0 && rope_lane) {
                        const int i0 = ((c0 - 4096) >> 3) * 4;
                        const f32x4 c = cv[ai * 4 + m], sn = sv[ai * 4 + m];
                        const f32x4 o1 = v0 * c - v1 * sn, o2 = v0 * sn + v1 * c;
                        *(u32x2*)(kpe + (size_t)r * 64 + i0) = pack4(o1);
                        *(u32x2*)(kpe + (size_t)r * 64 + 32 + i0) = pack4(o2);
                    } else if (c0 < EVIN) {
                        *(u32x4*)(P + (size_t)r * LDP + c0) = pack8(v0, v1);
                        ss += dot4(v0) + dot4(v1);
                    }
                }
                if (do_ssq) { ss += __shfl_xor(ss, 16); ss += __shfl_xor(ss, 32); if (fq == 0) ssq[(size_t)r * 16 + (u.pn - 12) * 4 + wc] = ss; }
            }
    }
};
DI float ssq8(const float* p) { const f32x4 a = *(const f32x4*)p, b = *(const f32x4*)(p + 4); return ((a[0] + a[1]) + (a[2] + a[3])) + ((b[0] + b[1]) + (b[2] + b[3])); }
struct EpiQ {
    static constexpr bool PRE = false;
    static constexpr bool AFTER_DRAIN = false;
    static constexpr bool PERM = true;
    bf16_t* QH; const float* ssq;
    DI void operator()(const f32x4 (&acc)[2][2][4][2], const Unit& u, int wr, int wc, int fr, int fq) const {
        const int colt = u.pn * 256;
        const int rbase = u.pm * 256 + wr * 64 + fr;
        float rsv[8];
#pragma unroll
        for (int i = 0; i < 8; ++i) { const f32x2 t2 = *(const f32x2*)(ssq + (size_t)(rbase + (i >> 2) * 128 + (i & 3) * 16) * 16 + 2 * fq); rsv[i] = t2[0] + t2[1]; }
#pragma unroll
        for (int i = 0; i < 8; ++i) { float sq = rsv[i]; sq += __shfl_xor(sq, 16); sq += __shfl_xor(sq, 32); rsv[i] = rsqrtf(sq * (1.f / 512.f) + EPS_) * QSCALE; }
        EPI_FENCE();
#pragma unroll
        for (int bj = 0; bj < 2; ++bj) {
            const int c0 = colt + bj * 128 + wc * 32 + 8 * fq;
            const int h = c0 / 192, d0 = c0 - h * 192;
            const bool rope = d0 >= 128;
            const int i0 = rope ? ((d0 - 128) >> 3) * 4 : 0;
            f32x4 fr4;
#pragma unroll
            for (int e = 0; e < 4; ++e) fr4[e] = fexp2(-(float)(i0 + e) * (13.287712379549449f / 32.f)) * 0.15915494309189535f;
#pragma unroll
            for (int ai = 0; ai < 2; ++ai)
#pragma unroll
                for (int m = 0; m < 4; ++m) {
                    const int r = rbase + ai * 128 + m * 16;
                    const float rs = rsv[ai * 4 + m];
                    const int b = r >> 12, s = r & (SEQ - 1);
                    bf16_t* base = QH + ((size_t)(b * 8 + h) * SEQ + s) * 192;
                    const f32x4 v0 = acc[ai][bj][m][0] * rs, v1 = acc[ai][bj][m][1] * rs;
                    if (!rope) *(u32x4*)(base + d0) = pack8(v0, v1);
                    else {
                        f32x4 c, sn;
#pragma unroll
                        for (int e = 0; e < 4; ++e) { const float rev = (float)s * fr4[e]; const float fr_ = rev - floorf(rev); c[e] = __builtin_amdgcn_cosf(fr_); sn[e] = __builtin_amdgcn_sinf(fr_); }
                        const f32x4 o1 = v0 * c - v1 * sn, o2 = v0 * sn + v1 * c;
                        *(u32x2*)(base + 128 + i0) = pack4(o1);
                        *(u32x2*)(base + 160 + i0) = pack4(o2);
                    }
                }
        }
    }
};
struct EpiKV {
    static constexpr bool PRE = false;
    static constexpr bool AFTER_DRAIN = false;
    static constexpr bool PERM = true;
    bf16_t* KN; bf16_t* VT; const float* ssq;
    DI void operator()(const f32x4 (&acc)[2][2][4][2], const Unit& u, int wr, int wc, int fr, int fq) const {
        const int h = u.pn;
        const int rbase = u.pm * 256 + wr * 64 + fr;
        float rsv[8];
#pragma unroll
        for (int i = 0; i < 8; ++i) { const f32x2 t2 = *(const f32x2*)(ssq + (size_t)(rbase + (i >> 2) * 128 + (i & 3) * 16) * 16 + 8 + 2 * fq); rsv[i] = t2[0] + t2[1]; }
#pragma unroll
        for (int i = 0; i < 8; ++i) { float sq = rsv[i]; sq += __shfl_xor(sq, 16); sq += __shfl_xor(sq, 32); rsv[i] = rsqrtf(sq * (1.f / 512.f) + EPS_); }
        EPI_FENCE();
#pragma unroll
        for (int ai = 0; ai < 2; ++ai)
#pragma unroll
            for (int m = 0; m < 4; ++m) {
                const int r = rbase + ai * 128 + m * 16;
                const float rs = rsv[ai * 4 + m];
                const int b = r >> 12, s = r & (SEQ - 1);
                const int d = wc * 32 + 8 * fq;
                *(u32x4*)(KN + ((size_t)(b * 8 + h) * SEQ + s) * 128 + d) = pack8(acc[ai][0][m][0] * rs, acc[ai][0][m][1] * rs);
                *(u32x4*)(VT + ((size_t)(b * 8 + h) * SEQ + s) * 128 + d) = pack8(acc[ai][1][m][0] * rs, acc[ai][1][m][1] * rs);
            }
    }
};
struct EpiRes1 {
    static constexpr bool PRE = false;
    static constexpr bool AFTER_DRAIN = false;
    static constexpr bool PERM = true;
    const bf16_t* base; bf16_t* xb; float* ssq;
    DI void operator()(const f32x4 (&acc)[2][2][4][2], const Unit& u, int wr, int wc, int fr, int fq) const {
        const int col0 = u.pn * 256 + wc * 32 + 8 * fq;
        const int rbase = u.pm * 256 + wr * 64 + fr;
        u32x4 xw[8][2];
#pragma unroll
        for (int i = 0; i < 8; ++i)
#pragma unroll
            for (int bj = 0; bj < 2; ++bj) xw[i][bj] = *(const u32x4*)(base + (size_t)(rbase + (i >> 2) * 128 + (i & 3) * 16) * DM + col0 + bj * 128);
        EPI_FENCE();
#pragma unroll
        for (int ai = 0; ai < 2; ++ai)
#pragma unroll
            for (int m = 0; m < 4; ++m) {
                const int r = rbase + ai * 128 + m * 16;
                const size_t off = (size_t)r * DM + col0;
                float ss = 0.f;
#pragma unroll
                for (int bj = 0; bj < 2; ++bj) {
                    const u32x4 w = xw[ai * 4 + m][bj];
                    const f32x4 v0 = (f32x4){bflo(w.x), bfhi(w.x), bflo(w.y), bfhi(w.y)} + acc[ai][bj][m][0];
                    const f32x4 v1 = (f32x4){bflo(w.z), bfhi(w.z), bflo(w.w), bfhi(w.w)} + acc[ai][bj][m][1];
                    *(u32x4*)(xb + off + bj * 128) = pack8(v0, v1); ss += dot4(v0) + dot4(v1);
                }
                ss += __shfl_xor(ss, 16); ss += __shfl_xor(ss, 32); if (fq == 0) ssq[(size_t)r * 32 + u.pn * 4 + wc] = ss;
            }
    }
};
struct EpiRes2 {
    static constexpr bool PRE = false;
    static constexpr bool AFTER_DRAIN = false;
    static constexpr bool PERM = false;
    const bf16_t* xb; float* out;
    DI void operator()(const f32x4 (&acc)[2][2][4][2], const Unit& u, int wr, int wc, int fr, int fq) const {
        const int col0 = u.pn * 256 + wc * 32 + 4 * fq;
#pragma unroll
        for (int ai = 0; ai < 2; ++ai)
#pragma unroll
            for (int m = 0; m < 4; ++m) {
                const int r = u.pm * 256 + ai * 128 + wr * 64 + m * 16 + fr;
                const size_t off = (size_t)r * DM + col0;
#pragma unroll
                for (int bj = 0; bj < 2; ++bj)
#pragma unroll
                    for (int n = 0; n < 2; ++n) {
                        const u32x2 w = *(const u32x2*)(xb + off + bj * 128 + n * 16);
                        const f32x4 b4 = {bflo(w.x), bfhi(w.x), bflo(w.y), bfhi(w.y)};
                        *(f32x4*)(out + off + bj * 128 + n * 16) = b4 + acc[ai][bj][m][n];
                    }
            }
    }
};

struct EpiRes2N {
    static constexpr bool PRE = false;
    static constexpr bool PERM = true, AFTER_DRAIN = true;
    const bf16_t* xb; float* out; const float* fg; float* part; unsigned* cnt;
    DI void fused(f32x4 (&acc)[2][2][4][2], const Unit& u, int wr, int wc, int fr, int fq, LAS unsigned char* lds, int wid, int lane) const {
        LAS float* P = (LAS float*)lds;
        LAS float* R = (LAS float*)(lds + 4096);
        const int col0 = u.pn * 256 + wc * 32 + 8 * fq;
#pragma unroll
        for (int ai = 0; ai < 2; ++ai)
#pragma unroll
            for (int m = 0; m < 4; ++m) {
                const int rl = ai * 128 + wr * 64 + m * 16 + fr;
                const size_t off = (size_t)(u.pm * 256 + rl) * DM + col0;
                float ss = 0.f;
#pragma unroll
                for (int bj = 0; bj < 2; ++bj) {
                    const u32x4 w = *(const u32x4*)(xb + off + bj * 128);
                    acc[ai][bj][m][0] += (f32x4){bflo(w.x), bfhi(w.x), bflo(w.y), bfhi(w.y)};
                    acc[ai][bj][m][1] += (f32x4){bflo(w.z), bfhi(w.z), bflo(w.w), bfhi(w.w)};
                    ss += dot4(acc[ai][bj][m][0]) + dot4(acc[ai][bj][m][1]);
                }
                ss += __shfl_xor(ss, 16); ss += __shfl_xor(ss, 32);
                if (fq == 0) P[rl * 4 + wc] = ss;
            }
        __syncthreads();
        const int tid = wid * 64 + lane;
        if (tid < 256) {
            const f32x4 p4 = *(LAS f32x4*)(P + tid * 4);
            __hip_atomic_store(part + (size_t)(u.pm * 256 + tid) * 8 + u.pn, (p4[0] + p4[1]) + (p4[2] + p4[3]), __ATOMIC_RELAXED, __HIP_MEMORY_SCOPE_AGENT);
        }
        asm volatile("s_waitcnt vmcnt(0)" ::: "memory");
        __syncthreads();
        if (tid == 0) {
            __builtin_amdgcn_fence(__ATOMIC_RELEASE, "agent");
            __hip_atomic_fetch_add(cnt + 64 * u.pm, 1u, __ATOMIC_RELAXED, __HIP_MEMORY_SCOPE_AGENT);
            unsigned sp = 0;
            while (__hip_atomic_load(cnt + 64 * u.pm, __ATOMIC_RELAXED, __HIP_MEMORY_SCOPE_AGENT) < 8u) { __builtin_amdgcn_s_sleep(1); if (++sp > (1u << 22)) break; }
            __builtin_amdgcn_fence(__ATOMIC_ACQUIRE, "agent");
        }
        __syncthreads();
        if (tid < 256) {
            const float* pp = part + (size_t)(u.pm * 256 + tid) * 8;
            float s = 0.f;
#pragma unroll
            for (int j = 0; j < 8; ++j) s += __hip_atomic_load(pp + j, __ATOMIC_RELAXED, __HIP_MEMORY_SCOPE_AGENT);
            R[tid] = rsqrtf(s * (1.f / 2048.f) + EPS_);
        }
        __syncthreads();
        f32x4 gv[2][2];
#pragma unroll
        for (int bj = 0; bj < 2; ++bj)
#pragma unroll
            for (int n = 0; n < 2; ++n) gv[bj][n] = *(const f32x4*)(fg + col0 + bj * 128 + n * 4);
#pragma unroll
        for (int ai = 0; ai < 2; ++ai)
#pragma unroll
            for (int m = 0; m < 4; ++m) {
                const int rl = ai * 128 + wr * 64 + m * 16 + fr;
                const float rs = R[rl];
                const size_t off = (size_t)(u.pm * 256 + rl) * DM + col0;
#pragma unroll
                for (int bj = 0; bj < 2; ++bj)
#pragma unroll
                    for (int n = 0; n < 2; ++n) *(f32x4*)(out + off + bj * 128 + n * 4) = acc[ai][bj][m][n] * rs * gv[bj][n];
            }
    }
};
struct EpiHg {
    static constexpr bool PRE = false;
    static constexpr bool AFTER_DRAIN = false;
    static constexpr bool PERM = true;
    unsigned char* ws; bf16_t* LOGF; const float* ssq; const float* lb;
    DI void operator()(const f32x4 (&acc)[2][2][4][2], const Unit& u, int wr, int wc, int fr, int fq) const {
        const int seg = u.pn >> 3, colt = (u.pn & 7) * 256;
        const size_t dsto = (size_t)(seg == 0) * WS_Q2 + (size_t)(seg == 2) * WS_IV + (size_t)(seg == 3) * WS_G2;
        bf16_t* dst = (bf16_t*)(ws + dsto);
        const int rbase = u.pm * 256 + wr * 64 + fr;
        float rsv[8];
#pragma unroll
        for (int i = 0; i < 8; ++i) rsv[i] = ssq8(ssq + (size_t)(rbase + (i >> 2) * 128 + (i & 3) * 16) * 32 + 8 * fq);
#pragma unroll
        for (int i = 0; i < 8; ++i) { float sq = rsv[i]; sq += __shfl_xor(sq, 16); sq += __shfl_xor(sq, 32); rsv[i] = rsqrtf(sq * (1.f / 2048.f) + EPS_); }
        EPI_FENCE();
#pragma unroll
        for (int ai = 0; ai < 2; ++ai)
#pragma unroll
            for (int m = 0; m < 4; ++m) {
                const int r = rbase + ai * 128 + m * 16;
                const float rs = rsv[ai * 4 + m];
#pragma unroll
                for (int bj = 0; bj < 2; ++bj) {
                    const int cc = colt + bj * 128 + wc * 32 + 8 * fq;
                    const f32x4 v0 = acc[ai][bj][m][0] * rs, v1 = acc[ai][bj][m][1] * rs;
                    const size_t off = (size_t)r * DM + cc;
                    if (seg == 2) {
                        const int bb = r >> 12, tt = r & (SEQ - 1), ch = tt >> 6, sl = tt & 63, hh = cc >> 7, vv0 = cc & 127;
                        bf16_t* vb = dst + ((size_t)(((bb * 16 + hh) * 64 + ch) * 128 + vv0)) * 64 + sl;
                        const u32x4 w = pack8(v0, v1);
                        vb[0 * 64] = (bf16_t)(w.x & 0xffff); vb[1 * 64] = (bf16_t)(w.x >> 16);
                        vb[2 * 64] = (bf16_t)(w.y & 0xffff); vb[3 * 64] = (bf16_t)(w.y >> 16);
                        vb[4 * 64] = (bf16_t)(w.z & 0xffff); vb[5 * 64] = (bf16_t)(w.z >> 16);
                        vb[6 * 64] = (bf16_t)(w.w & 0xffff); vb[7 * 64] = (bf16_t)(w.w >> 16);
                    } else if (seg == 1) {
                        u32x4 w; w.x = pkh2(v0[0], v0[1]); w.y = pkh2(v0[2], v0[3]); w.z = pkh2(v1[0], v1[1]); w.w = pkh2(v1[2], v1[3]);
                        *(u32x4*)(LOGF + off) = w;
                    } else {
                        *(u32x4*)(dst + off) = pack8(v0, v1);
                    }
                }
            }
    }
};

#define XB_TMO      128
#define XB_XCNT(j)  (256  + 64 * (j))
#define XB_XSUB(j)  (1280 + 64 * (j))
#define XB_XGEN(j)  (2304 + 64 * (j))
#define XB_TOP      3328
#define XB_TOPGEN   3392
#define XCD_BAR_WORDS 3456
#define XB_SPIN_CAP (1u << 18)
DI unsigned xb_ld(unsigned* p)              { return __hip_atomic_load(p, __ATOMIC_RELAXED, __HIP_MEMORY_SCOPE_AGENT); }
DI unsigned xb_add(unsigned* p, unsigned v) { return __hip_atomic_fetch_add(p, v, __ATOMIC_RELAXED, __HIP_MEMORY_SCOPE_AGENT); }
DI unsigned xb_xcc_id() { return (unsigned)__builtin_amdgcn_s_getreg((3 << 11) | 20) & 0xFu; }
#define XB_SPIN(cond, bar) do { unsigned _sp = 0; while (cond) { __builtin_amdgcn_s_sleep(1); \
    if ((++_sp & 255u) == 0u) { if (xb_ld(&(bar)[XB_TMO])) break; if (_sp > XB_SPIN_CAP) { atomicAdd(&(bar)[XB_TMO], 1u); break; } } } } while (0)
struct XcdBarrier { unsigned* bar; unsigned x; volatile LAS unsigned* st; };
DI XcdBarrier xcd_barrier_post(unsigned* bar, volatile LAS unsigned* st) {
    XcdBarrier b; b.bar = bar; b.x = xb_xcc_id(); b.st = st;
    if (threadIdx.x == 0) (void)xb_add(&bar[XB_XCNT(b.x)], 1u);
    return b;
}
DI void xcd_barrier_complete(unsigned* bar, unsigned x, unsigned& nloc, unsigned& nx) {
    const unsigned G = gridDim.x * gridDim.y * gridDim.z;
    unsigned sum, cnt, mine, sp = 0u;
    for (;;) {
        sum = 0u; cnt = 0u; mine = 0u;
#pragma unroll
        for (unsigned j = 0; j < 16; ++j) { const unsigned c = xb_ld(&bar[XB_XCNT(j)]); sum += c; cnt += (c > 0u) ? 1u : 0u; mine = (j == x) ? c : mine; }
        if (sum == G) break;
        __builtin_amdgcn_s_sleep(1);
        if ((++sp & 255u) == 0u) { if (xb_ld(&bar[XB_TMO])) break; if (sp > XB_SPIN_CAP) { atomicAdd(&bar[XB_TMO], 1u); break; } }
    }
    nloc = mine > 0u ? mine : 1u; nx = cnt > 0u ? cnt : 1u;
}
DI void xcd_barrier(const XcdBarrier& b) {
    asm volatile("s_waitcnt vmcnt(0)" ::: "memory");
    __syncthreads();
    if (threadIdx.x == 0) {
        unsigned* bar = b.bar;
        __builtin_amdgcn_s_waitcnt(0);
        unsigned nloc = b.st[0], nx = b.st[1];
        if (nloc == 0u) { xcd_barrier_complete(bar, b.x, nloc, nx); b.st[0] = nloc; b.st[1] = nx; }
        const unsigned old = xb_add(&bar[XB_XSUB(b.x)], 1u);
        const unsigned gen = old / nloc;
        if (old + 1u == (gen + 1u) * nloc) {
            __builtin_amdgcn_fence(__ATOMIC_RELEASE, "agent");
            asm volatile("s_waitcnt vmcnt(0)" ::: "memory");
            const unsigned og = xb_add(&bar[XB_TOP], 1u);
            const unsigned tg = og / nx;
            if (og + 1u == (tg + 1u) * nx) xb_add(&bar[XB_TOPGEN], 1u);
            else XB_SPIN(xb_ld(&bar[XB_TOPGEN]) == tg, bar);
            __builtin_amdgcn_fence(__ATOMIC_ACQUIRE, "agent");
            xb_add(&bar[XB_XGEN(b.x)], 1u);
            asm volatile("s_waitcnt vmcnt(0)" ::: "memory");
        } else {
            XB_SPIN(xb_ld(&bar[XB_XGEN(b.x)]) == gen, bar);
            __builtin_amdgcn_fence(__ATOMIC_ACQUIRE, "agent");
            asm volatile("s_waitcnt vmcnt(0)" ::: "memory");
        }
    }
    __syncthreads();
}

struct Args {
    const float* in[18];
    float* out; unsigned char* ws;
    int ph_lo, ph_hi, flags, li;
};

template <int MAP> DI int map_row(int n) {
    if (MAP == 1) {
        if (n >= 4096 && n < 4160) { const int d = n - 4096, i = d & 31, hi = d >> 5; return 4096 + 8 * (i >> 2) + 4 * hi + (i & 3); }
        return n;
    }
    if (MAP == 2) {
        const int h = n / 192, d = n - h * 192;
        if (d >= 128) { const int dd = d - 128, i = dd & 31, hi = dd >> 5; return h * 192 + 128 + 8 * (i >> 2) + 4 * hi + (i & 3); }
        return n;
    }
    return n;
}
struct P0Desc { const float* W; const float* gain; bf16_t* WT; int K, N, nblk, map, item; };
DI void p0_load(const P0Desc& d, int lane, f32x4 (&v)[16]) {
    const int kb = d.item / d.nblk, nb = d.item - kb * d.nblk;
    const float* p = d.W + (size_t)(64 * kb + 16 * (lane >> 4)) * d.N + 64 * nb + (lane & 15) * 4;
#pragma unroll
    for (int i = 0; i < 16; ++i) v[i] = *(const f32x4*)(p + (size_t)i * d.N);
}
DI int map_row_rt(int map, int n) { return map == 1 ? map_row<1>(n) : (map == 2 ? map_row<2>(n) : n); }
DI void p0_store(const P0Desc& d, int lane, const f32x4 (&v)[16], LAS unsigned* scr) {
    const int kb = d.item / d.nblk, nb = d.item - kb * d.nblk, k0 = 64 * kb, n0 = 64 * nb, g = lane >> 4, l15 = lane & 15;
    f32x4 gg[4];
#pragma unroll
    for (int q = 0; q < 4; ++q) gg[q] = d.gain ? *(const f32x4*)(d.gain + k0 + 16 * g + 4 * q) : (f32x4){1.f, 1.f, 1.f, 1.f};
#pragma unroll
    for (int p = 0; p < 8; ++p) {
        const float ga = gg[(2 * p) >> 2][(2 * p) & 3], gb = gg[(2 * p + 1) >> 2][(2 * p + 1) & 3];
#pragma unroll
        for (int e = 0; e < 4; ++e) scr[(4 * l15 + e) * 33 + 8 * g + p] = pk2(v[2 * p][e] * ga, v[2 * p + 1][e] * gb);
    }
    asm volatile("s_waitcnt lgkmcnt(0)" ::: "memory");
    const int c = lane & 7;
#pragma unroll
    for (int j = 0; j < 8; ++j) {
        const int n = (lane >> 3) + 8 * j;
        const LAS unsigned* sp = scr + n * 33 + 4 * c;
        u32x4 o; o.x = sp[0]; o.y = sp[1]; o.z = sp[2]; o.w = sp[3];
        *(u32x4*)(d.WT + (size_t)map_row_rt(d.map, n0 + n) * d.K + k0 + 8 * c) = o;
    }
    asm volatile("s_waitcnt lgkmcnt(0)" ::: "memory");
}

DI void conv_item(LAS unsigned char* lds, int item, const bf16_t* P, const float* cw, const float* cb, const float* lng, const float* lnb, bf16_t* MIX) {
    LAS float* U = (LAS float*)lds;
    const int tid = threadIdx.x, lane = tid & 63, wid = tid >> 6;
    const int tt0 = (item >> 3) * 128, g = item & 7, cbase = g * 128;
    const int bstart = tt0 & ~(SEQ - 1);
    {
        u32x4 vv[5], gv[5];
#pragma unroll
        for (int j = 0; j < 5; ++j) {
            const int id = tid + 512 * j, row = id >> 4, c8 = (id & 15) * 8, tt = tt0 - 30 + row;
            vv[j] = (u32x4){0u, 0u, 0u, 0u}; gv[j] = vv[j];
            if (id < 158 * 16 && tt >= bstart) { vv[j] = *(const u32x4*)(P + (size_t)tt * LDP + cbase + c8); gv[j] = *(const u32x4*)(P + (size_t)tt * LDP + 1024 + cbase + c8); }
        }
#pragma unroll
        for (int j = 0; j < 5; ++j) {
            const int id = tid + 512 * j, row = id >> 4, c8 = (id & 15) * 8;
            const u32x4 v = vv[j], gg = gv[j];
            f32x4 u0, u1;
            u0[0] = bflo(v.x) * sigmoidf_(bflo(gg.x)); u0[1] = bfhi(v.x) * sigmoidf_(bfhi(gg.x));
            u0[2] = bflo(v.y) * sigmoidf_(bflo(gg.y)); u0[3] = bfhi(v.y) * sigmoidf_(bfhi(gg.y));
            u1[0] = bflo(v.z) * sigmoidf_(bflo(gg.z)); u1[1] = bfhi(v.z) * sigmoidf_(bfhi(gg.z));
            u1[2] = bflo(v.w) * sigmoidf_(bflo(gg.w)); u1[3] = bfhi(v.w) * sigmoidf_(bfhi(gg.w));
            if (id < 158 * 16) { *(LAS f32x4*)(U + row * 128 + c8) = u0; *(LAS f32x4*)(U + row * 128 + c8 + 4) = u1; }
        }
    }
    __syncthreads();
    const int c = tid & 127, tq = tid >> 7;
    float y[32];
    {
        float w[31];
#pragma unroll
        for (int k = 0; k < 31; ++k) w[k] = cw[k * 1024 + cbase + c];
        const float bias = cb[cbase + c];
#pragma unroll
        for (int i = 0; i < 32; ++i) y[i] = bias;
        float uw[62];
#pragma unroll
        for (int j = 0; j < 62; ++j) uw[j] = U[(tq * 32 + j) * 128 + c];
#pragma unroll
        for (int i = 0; i < 32; ++i)
#pragma unroll
            for (int k = 0; k < 31; ++k) y[i] += w[k] * uw[i + k];
    }
    __syncthreads();
#pragma unroll
    for (int i = 0; i < 32; ++i) U[(tq * 32 + i) * 128 + c] = y[i];
    __syncthreads();
    {
        const int ts = lane >> 4, cl = lane & 15, ca = 4 * cl, cb2 = 64 + 4 * cl;
        const f32x4 ga = *(const f32x4*)(lng + cbase + ca), gb = *(const f32x4*)(lng + cbase + cb2);
        const f32x4 ba = *(const f32x4*)(lnb + cbase + ca), bb = *(const f32x4*)(lnb + cbase + cb2);
#pragma unroll
        for (int it = 0; it < 4; ++it) {
            const int t = wid * 16 + it * 4 + ts;
            const size_t row = (size_t)(tt0 + t);
            const u32x2 za = *(const u32x2*)(P + row * LDP + 2048 + cbase + ca), zb = *(const u32x2*)(P + row * LDP + 2048 + cbase + cb2);
            f32x4 va = *(LAS f32x4*)(U + t * 128 + ca), vb = *(LAS f32x4*)(U + t * 128 + cb2);
            float sm = ((va[0] + va[1]) + (va[2] + va[3])) + ((vb[0] + vb[1]) + (vb[2] + vb[3]));
            sm += __shfl_xor(sm, 1); sm += __shfl_xor(sm, 2); sm += __shfl_xor(sm, 4); sm += __shfl_xor(sm, 8);
            const float mu = sm * (1.f / 128.f);
            va = va - mu; vb = vb - mu;
            float sq = dot4(va) + dot4(vb);
            sq += __shfl_xor(sq, 1); sq += __shfl_xor(sq, 2); sq += __shfl_xor(sq, 4); sq += __shfl_xor(sq, 8);
            const float rstd = rsqrtf(sq * (1.f / 128.f) + EPS_);
            f32x4 oa = va * rstd * ga + ba, ob = vb * rstd * gb + bb;
            oa[0] = siluf_(oa[0]) * siluf_(bflo(za.x)); oa[1] = siluf_(oa[1]) * siluf_(bfhi(za.x)); oa[2] = siluf_(oa[2]) * siluf_(bflo(za.y)); oa[3] = siluf_(oa[3]) * siluf_(bfhi(za.y));
            ob[0] = siluf_(ob[0]) * siluf_(bflo(zb.x)); ob[1] = siluf_(ob[1]) * siluf_(bfhi(zb.x)); ob[2] = siluf_(ob[2]) * siluf_(bflo(zb.y)); ob[3] = siluf_(ob[3]) * siluf_(bfhi(zb.y));
            *(u32x2*)(MIX + row * DM + cbase + ca) = pack4(oa); *(u32x2*)(MIX + row * DM + cbase + cb2) = pack4(ob);
        }
    }
    __syncthreads();
}

constexpr int KROW = 400, VROW = 320, KBUF_B = 64 * KROW, VBUF_B = 64 * VROW, ATT_STAGE = KBUF_B + VBUF_B;
DI void attn_item(LAS unsigned char* lds, int bh, int qb, const bf16_t* QH, const bf16_t* KN, const bf16_t* KPE, const bf16_t* VT, const bf16_t* P, bf16_t* MIX) {
    const int tid = threadIdx.x, lane = tid & 63, wid = __builtin_amdgcn_readfirstlane(tid >> 6);
    const int rg = wid & 3, kh = wid >> 2, r = lane & 31, h2 = lane >> 5;
    const int b = bh >> 3, h = bh & 7;
    const int q0 = qb * 128;
    const int ntile = 2 * (qb + 1);
    const bf16_t* ksrc[3]; int kdst[3];
#pragma unroll
    for (int j = 0; j < 3; ++j) { const int id = tid + 512 * j, key = id / 24, ch = id - key * 24;
        ksrc[j] = ch < 16 ? KN + ((size_t)bh * SEQ + key) * 128 + ch * 8 : KPE + ((size_t)b * SEQ + key) * 64 + (ch - 16) * 8;
        kdst[j] = key * KROW + ch * 16; }
    const bf16_t* vsrc[2]; int vdst[2];
#pragma unroll
    for (int j = 0; j < 2; ++j) { const int id = tid + 512 * j, key = id >> 4, ch = id & 15;
        vsrc[j] = VT + ((size_t)bh * SEQ + key) * 128 + ch * 8; vdst[j] = key * VROW + ch * 16; }
    const size_t kstep_n = (size_t)64 * 128, kstep_p = (size_t)64 * 64;
    u32x4 kreg[3], vreg[2];
#define ATT_LOAD(t) do { _Pragma("unroll") for (int j = 0; j < 3; ++j) { const int id = tid + 512 * j; const int ch = id % 24; kreg[j] = *(const u32x4*)(ksrc[j] + (size_t)(t) * (ch < 16 ? kstep_n : kstep_p)); } \
        _Pragma("unroll") for (int j = 0; j < 2; ++j) vreg[j] = *(const u32x4*)(vsrc[j] + (size_t)(t) * 8192); } while (0)
#define ATT_STORE(buf) do { LAS unsigned char* kb_ = lds + (buf) * ATT_STAGE; LAS unsigned char* vb_ = kb_ + KBUF_B; \
        _Pragma("unroll") for (int j = 0; j < 3; ++j) *(LAS u32x4*)(kb_ + kdst[j]) = kreg[j]; \
        _Pragma("unroll") for (int j = 0; j < 2; ++j) *(LAS u32x4*)(vb_ + vdst[j]) = vreg[j]; } while (0)
    ATT_LOAD(0);
    bf16x8 Qf[12];
    { const bf16_t* qp = QH + ((size_t)bh * SEQ + q0 + rg * 32 + r) * 192 + 8 * h2;
#pragma unroll
      for (int ks = 0; ks < 12; ++ks) Qf[ks] = *(const bf16x8*)(qp + 16 * ks); }
    ATT_STORE(0);
    ATT_LOAD(1);
    f32x16 O[4];
#pragma unroll
    for (int d = 0; d < 4; ++d)
#pragma unroll
        for (int i = 0; i < 16; ++i) O[d][i] = 0.f;
    const float NEG = -1e30f;
    float mrow = NEG, lrow = 0.f;
    const int qpos = q0 + rg * 32 + r;
    for (int t = 0; t < ntile; ++t) {
        __syncthreads();
        if (t + 1 < ntile) { ATT_STORE((t + 1) & 1); if (t + 2 < ntile) ATT_LOAD(t + 2); }
        LAS unsigned char* kb = lds + (t & 1) * ATT_STAGE; LAS unsigned char* vb = kb + KBUF_B;
        f32x16 S;
#pragma unroll
        for (int i = 0; i < 16; ++i) S[i] = 0.f;
        { const LAS unsigned char* kp = kb + (kh * 32 + r) * KROW + 16 * h2;
          __builtin_amdgcn_s_setprio(1);
#pragma unroll
          for (int ks = 0; ks < 12; ++ks) { const bf16x8 a = *(const LAS bf16x8*)(kp + 32 * ks); S = __builtin_amdgcn_mfma_f32_32x32x16_bf16(a, Qf[ks], S, 0, 0, 0); }
          __builtin_amdgcn_sched_group_barrier(0x100, 4, 0);
#pragma unroll
          for (int i = 0; i < 8; ++i) { __builtin_amdgcn_sched_group_barrier(0x008, 1, 0); __builtin_amdgcn_sched_group_barrier(0x100, 1, 0); }
          __builtin_amdgcn_sched_group_barrier(0x008, 4, 0);
          __builtin_amdgcn_s_setprio(0); }
        const bool diag = (t >= 2 * qb);
        if (diag) {
            const int key0 = t * 64 + kh * 32 + 4 * h2;
#pragma unroll
            for (int i = 0; i < 16; ++i) { const int key = key0 + (i & 3) + 8 * (i >> 2); if (key > qpos) S[i] = NEG; }
        }
        float mx = S[0];
#pragma unroll
        for (int i = 1; i < 16; ++i) mx = fmaxf(mx, S[i]);
        mx = fmaxf(mx, __shfl_xor(mx, 32));
        if (__any(mx > mrow + 8.f)) {
            const float mnew = fmaxf(mrow, mx);
            const float alpha = fexp2(mrow - mnew);
            mrow = mnew; lrow *= alpha;
#pragma unroll
            for (int d = 0; d < 4; ++d)
#pragma unroll
                for (int i = 0; i < 16; ++i) O[d][i] *= alpha;
        }
        float ps = 0.f;
#pragma unroll
        for (int i = 0; i < 16; ++i) { float p = fexp2(S[i] - mrow); if (diag && S[i] == NEG) p = 0.f; S[i] = p; ps += p; }
        lrow += ps;
        bf16x8 pb[2];
#pragma unroll
        for (int s2 = 0; s2 < 2; ++s2) { u32x4 w; w.x = pk2(S[8 * s2 + 0], S[8 * s2 + 1]); w.y = pk2(S[8 * s2 + 2], S[8 * s2 + 3]); w.z = pk2(S[8 * s2 + 4], S[8 * s2 + 5]); w.w = pk2(S[8 * s2 + 6], S[8 * s2 + 7]); pb[s2] = __builtin_bit_cast(bf16x8, w); }
        __builtin_amdgcn_s_setprio(1);
        {
            const int li = lane & 15, gd = (lane >> 4) & 1;
            const LAS unsigned char* vp = vb + (kh * 32 + 4 * h2 + (li >> 2)) * VROW + gd * 32 + (li & 3) * 8;
#pragma unroll
            for (int d = 0; d < 4; ++d)
#pragma unroll
                for (int s2 = 0; s2 < 2; ++s2) {
                    const s16x4 lo = __builtin_amdgcn_ds_read_tr16_b64_v4i16((LAS s16x4*)(vp + (16 * s2) * VROW + 64 * d));
                    const s16x4 hi = __builtin_amdgcn_ds_read_tr16_b64_v4i16((LAS s16x4*)(vp + (16 * s2 + 8) * VROW + 64 * d));
                    const bf16x8 av = __builtin_shufflevector(lo, hi, 0, 1, 2, 3, 4, 5, 6, 7);
                    O[d] = __builtin_amdgcn_mfma_f32_32x32x16_bf16(av, pb[s2], O[d], 0, 0, 0);
                }
            __builtin_amdgcn_sched_group_barrier(0x100, 4, 0);
#pragma unroll
            for (int i = 0; i < 6; ++i) { __builtin_amdgcn_sched_group_barrier(0x008, 1, 0); __builtin_amdgcn_sched_group_barrier(0x100, 2, 0); }
            __builtin_amdgcn_sched_group_barrier(0x008, 2, 0);
        }
        __builtin_amdgcn_s_setprio(0);
    }
    __syncthreads();
#undef ATT_LOAD
#undef ATT_STORE
    lrow += __shfl_xor(lrow, 32);
    LAS float* mb = (LAS float*)lds + (rg * 64 + lane) * 66;
    if (kh == 1) {
#pragma unroll
        for (int d = 0; d < 4; ++d)
#pragma unroll
            for (int i = 0; i < 16; ++i) mb[d * 16 + i] = O[d][i];
        mb[64] = mrow; mb[65] = lrow;
    }
    __syncthreads();
    LAS unsigned char* OBa = lds + 69632;
    if (kh == 0) {
        const float m2 = mb[64], l2 = mb[65];
        const float mn = fmaxf(mrow, m2), w1 = fexp2(mrow - mn), w2 = fexp2(m2 - mn);
        const float inv = frcp(lrow * w1 + l2 * w2);
#pragma unroll
        for (int d = 0; d < 4; ++d)
#pragma unroll
            for (int g4 = 0; g4 < 4; ++g4) {
                const int dd = 32 * d + 8 * g4 + 4 * h2;
                f32x4 o;
#pragma unroll
                for (int e = 0; e < 4; ++e) o[e] = (O[d][4 * g4 + e] * w1 + mb[d * 16 + 4 * g4 + e] * w2) * inv;
                *(LAS u32x2*)(OBa + (rg * 32 + r) * 272 + dd * 2) = pack4(o);
            }
    }
    __syncthreads();
    {
        const bf16_t* zp = P + ((size_t)b * SEQ + q0) * LDP + 4160 + h * 128;
        bf16_t* op = MIX + ((size_t)b * SEQ + q0) * DM + 1024 + h * 128;
#pragma nounroll
        for (int j = 0; j < 4; ++j) {
            const int id = tid + 512 * j, q = id >> 4, c8 = (id & 15) * 8;
            const u32x4 ov = *(const LAS u32x4*)(OBa + q * 272 + c8 * 2);
            const u32x4 z = *(const u32x4*)(zp + (size_t)q * LDP + c8);
            f32x4 o0, o1;
            o0[0] = bflo(ov.x) * siluf_(bflo(z.x)); o0[1] = bfhi(ov.x) * siluf_(bfhi(z.x)); o0[2] = bflo(ov.y) * siluf_(bflo(z.y)); o0[3] = bfhi(ov.y) * siluf_(bfhi(z.y));
            o1[0] = bflo(ov.z) * siluf_(bflo(z.z)); o1[1] = bfhi(ov.z) * siluf_(bfhi(z.z)); o1[2] = bflo(ov.w) * siluf_(bflo(z.w)); o1[3] = bfhi(ov.w) * siluf_(bfhi(z.w));
            *(u32x4*)(op + (size_t)q * DM + c8) = pack8(o0, o1);
        }
    }
    __syncthreads();
}

constexpr int HROW = 272, TROW = 144;
DI bf16_t* ds_item_ptr(unsigned char* ws, unsigned char* ob, int b, int h, int c) { return (bf16_t*)(b == 0 ? ws + WS_DS0 : ob) + ((size_t)(h * 64 + c)) * 16384; }
DI void hg_iv_load(const bf16_t* IVT, int item, u32x4 (&w)[2]) {
    const int tid = threadIdx.x;
#pragma unroll
    for (int j = 0; j < 2; ++j) w[j] = *(const u32x4*)(IVT + (size_t)item * 8192 + (size_t)(tid + 512 * j) * 8);
}
DI void hg_iv_store(LAS unsigned char* VTs, const u32x4 (&wv)[2]) {
    const int tid = threadIdx.x;
#pragma unroll
    for (int j = 0; j < 2; ++j) { const int id = tid + 512 * j, v = id >> 3, ch = id & 7; *(LAS u32x4*)(VTs + v * TROW + ch * 16) = wv[j]; }
}
DI void hgA_load(unsigned char* ws, int item, unsigned (&lf)[16], u32x4 (&ivw)[2]) {
    const int tid = threadIdx.x, b = item >> 10, h = (item >> 6) & 15, c = item & 63, t0 = b * SEQ + c * 64, k = tid & 127, tq = tid >> 7;
    const bf16_t* LOGF = (const bf16_t*)(ws + WS_LOGF);
#pragma unroll
    for (int i = 0; i < 16; ++i) lf[i] = LOGF[(size_t)(t0 + tq * 16 + i) * DM + h * 128 + k];
    hg_iv_load((const bf16_t*)(ws + WS_IV), item, ivw);
}
DI void hgC_load(unsigned char* ws, int item, unsigned (&lf)[16], unsigned (&qv)[16], u32x4 (&ivw)[2]) {
    const int tid = threadIdx.x, b = item >> 10, h = (item >> 6) & 15, c = item & 63, t0 = b * SEQ + c * 64, k = tid & 127, tq = tid >> 7;
    const bf16_t* LOGF = (const bf16_t*)(ws + WS_LOGF);
    const bf16_t* Q2 = (const bf16_t*)(ws + WS_Q2);
#pragma unroll
    for (int i = 0; i < 16; ++i) { const size_t o = (size_t)(t0 + tq * 16 + i) * DM + h * 128 + k; lf[i] = LOGF[o]; qv[i] = Q2[o]; }
    hg_iv_load((const bf16_t*)(ws + WS_IV), item, ivw);
}
DI void hgA_item(LAS unsigned char* lds, unsigned char* ws, unsigned char* ob, int item, const unsigned (&lfr)[16], const u32x4 (&ivw)[2], const float* lbp) {
    const int tid = threadIdx.x, lane = tid & 63, wid = __builtin_amdgcn_readfirstlane(tid >> 6);
    const int b = item >> 10, h = (item >> 6) & 15, c = item & 63;
    const int t0 = b * SEQ + c * 64;
    LAS unsigned char* KTs = lds;
    LAS unsigned char* VTs = lds + 128 * TROW;
    LAS float* tot = (LAS float*)(lds + 2 * 128 * TROW);
    const int k = tid & 127, tq = tid >> 7;
    float lf[16], kk[16];
    { const float lbk = lbp[h * 128 + (tid & 127)];
#pragma unroll
      for (int i = 0; i < 16; ++i) { const float om = (1.f - lbk) * sigmoidf_(-h2f((unsigned short)lfr[i])); kk[i] = om; lf[i] = flog(1.f - om); } }
    float cs[16]; float run = 0.f;
#pragma unroll
    for (int i = 0; i < 16; ++i) { run += lf[i]; cs[i] = run; }
    tot[tq * 128 + k] = run;
    hg_iv_store(VTs, ivw);
    __syncthreads();
    const float t0s = tot[k], t1s = tot[128 + k], t2s = tot[256 + k], t3s = tot[384 + k];
    const float off = (tq > 0 ? t0s : 0.f) + (tq > 1 ? t1s : 0.f) + (tq > 2 ? t2s : 0.f);
    const float blast = (t0s + t1s) + (t2s + t3s);
    {
        float kt[16];
#pragma unroll
        for (int i = 0; i < 16; ++i) kt[i] = kk[i] * fexp(blast - (off + cs[i]));
        u32x4 w0, w1;
        w0.x = pk2(kt[0], kt[1]); w0.y = pk2(kt[2], kt[3]); w0.z = pk2(kt[4], kt[5]); w0.w = pk2(kt[6], kt[7]);
        w1.x = pk2(kt[8], kt[9]); w1.y = pk2(kt[10], kt[11]); w1.z = pk2(kt[12], kt[13]); w1.w = pk2(kt[14], kt[15]);
        *(LAS u32x4*)(KTs + k * TROW + tq * 32) = w0; *(LAS u32x4*)(KTs + k * TROW + tq * 32 + 16) = w1;
    }
    if (tq == 0) ((float*)(ws + WS_DEC))[(size_t)item * 128 + k] = fexp(blast);
    __syncthreads();
    const int vb = wid & 3, kb2 = wid >> 2, r = lane & 31, h2 = lane >> 5;
    f32x16 a0, a1;
#pragma unroll
    for (int i = 0; i < 16; ++i) { a0[i] = 0.f; a1[i] = 0.f; }
#pragma unroll
    for (int ks = 0; ks < 4; ++ks) {
        const bf16x8 av = *(const LAS bf16x8*)(VTs + (32 * vb + r) * TROW + (16 * ks + 8 * h2) * 2);
        const bf16x8 b0 = *(const LAS bf16x8*)(KTs + (64 * kb2 + 2 * r) * TROW + (16 * ks + 8 * h2) * 2);
        const bf16x8 b1 = *(const LAS bf16x8*)(KTs + (64 * kb2 + 2 * r + 1) * TROW + (16 * ks + 8 * h2) * 2);
        a0 = __builtin_amdgcn_mfma_f32_32x32x16_bf16(av, b0, a0, 0, 0, 0);
        a1 = __builtin_amdgcn_mfma_f32_32x32x16_bf16(av, b1, a1, 0, 0, 0);
    }
    bf16_t* D = ds_item_ptr(ws, ob, b, h, c);
#pragma unroll
    for (int i = 0; i < 16; ++i) {
        const int v = 32 * vb + (i & 3) + 8 * (i >> 2) + 4 * h2;
        *(unsigned*)(D + v * 128 + 64 * kb2 + 2 * r) = pk2(a0[i], a1[i]);
    }
    __syncthreads();
}
DI void hgB(unsigned char* ws, unsigned char* ob, int G, int dummy) {
    const float* DEC = (const float*)(ws + WS_DEC);
    for (int gid = blockIdx.x * 512 + threadIdx.x; gid < 32 * 4096; gid += G * 512) {
        const int bh = gid >> 12, e4 = gid & 4095, v = e4 >> 5, k4 = (e4 & 31) * 4;
        const int b = bh >> 4, h = bh & 15;
        bf16_t* D = ds_item_ptr(ws, ob, b, h, 0) + v * 128 + k4;
        const float* dc = DEC + (size_t)bh * 64 * 128 + k4;
        f32x4 S = {0.f, 0.f, 0.f, 0.f};
        for (int cb = 0; cb < 64; cb += 8) {
            u32x2 w[8]; f32x4 d[8];
#pragma unroll
            for (int j = 0; j < 8; ++j) { w[j] = *(const u32x2*)(D + (size_t)(cb + j) * 16384); d[j] = *(const f32x4*)(dc + (cb + j) * 128); }
#pragma unroll
            for (int j = 0; j < 8; ++j) {
                bf16_t* dp = D + (size_t)(cb + j) * 16384;
                if (dummy) dp = (bf16_t*)(ws + WS_DUMMY) + ((((size_t)(h * 64 + cb + j)) * 16384 + v * 128 + k4) & (8 * MiB - 1));
                *(u32x2*)dp = pack4(S);
                const f32x4 ds = {bflo(w[j].x), bfhi(w[j].x), bflo(w[j].y), bfhi(w[j].y)};
                S = d[j] * S + ds;
            }
        }
    }
}
DI void hgC_item(LAS unsigned char* lds, unsigned char* ws, unsigned char* ob, int item, const float* ng, int dummy, const unsigned (&lfr)[16], const unsigned (&qvr)[16], const u32x4 (&ivw)[2], const float* lbp) {
    const int tid = threadIdx.x, lane = tid & 63, wid = __builtin_amdgcn_readfirstlane(tid >> 6);
    const int b = item >> 10, h = (item >> 6) & 15, c = item & 63;
    const int t0 = b * SEQ + c * 64;
    const bf16_t* G2 = (const bf16_t*)(ws + WS_G2);
    bf16_t* MIX2 = (bf16_t*)(ws + WS_Q2);
    if (dummy) MIX2 = (bf16_t*)(ws + WS_DUMMY) - (size_t)(t0 & ~4095) * DM;
    LAS unsigned char* QI = lds;
    LAS unsigned char* QA = lds + 64 * HROW;
    LAS unsigned char* KA = lds + 2 * 64 * HROW;
    LAS unsigned char* VTs = lds + 3 * 64 * HROW;
    LAS float* tot = (LAS float*)(lds + 3 * 64 * HROW + 128 * TROW);
    LAS float* red = tot + 512;
    const int k = tid & 127, tq = tid >> 7;
    const int vb = wid & 3, tb = wid >> 2, r = lane & 31, h2 = lane >> 5;
    LAS unsigned char* SS = lds + 73728;
    u32x4 sreg[4], gz[2];
    { const bf16_t* Sg = ds_item_ptr(ws, ob, b, h, c);
#pragma unroll
      for (int j = 0; j < 4; ++j) sreg[j] = *(const u32x4*)(Sg + (size_t)(tid + 512 * j) * 8);
#pragma unroll
      for (int j = 0; j < 2; ++j) { const int id = tid + 512 * j; gz[j] = *(const u32x4*)(G2 + (size_t)(t0 + (id >> 4)) * DM + h * 128 + (id & 15) * 8); } }
    float lf[16], kk[16];
    { const float lbk = lbp[h * 128 + (tid & 127)];
#pragma unroll
      for (int i = 0; i < 16; ++i) { const float om = (1.f - lbk) * sigmoidf_(-h2f((unsigned short)lfr[i])); kk[i] = om; lf[i] = flog(1.f - om); } }
    float qv[16];
#pragma unroll
    for (int i = 0; i < 16; ++i) qv[i] = bf2f((unsigned short)qvr[i]);
    float cs[16]; float run = 0.f;
#pragma unroll
    for (int i = 0; i < 16; ++i) { run += lf[i]; cs[i] = run; }
    tot[tq * 128 + k] = run;
    hg_iv_store(VTs, ivw);
#pragma unroll
    for (int j = 0; j < 4; ++j) { const int id = tid + 512 * j; *(LAS u32x4*)(SS + (id >> 4) * HROW + (id & 15) * 16) = sreg[j]; }
    __syncthreads();
    {
        const float t0s = tot[k], t1s = tot[128 + k], t2s = tot[256 + k];
        const float off = (tq > 0 ? t0s : 0.f) + (tq > 1 ? t1s : 0.f) + (tq > 2 ? t2s : 0.f);
        const float bref = t0s + t1s;
#pragma unroll
        for (int i = 0; i < 16; ++i) {
            const float bb = off + cs[i];
            const int t = tq * 16 + i;
            const float qi = qv[i] * fexp(bb);
            const float qa = qv[i] * fexp(fminf(bb - bref, 80.f));
            const float ka = kk[i] * fexp(fminf(bref - bb, 80.f));
            *(LAS bf16_t*)(QI + t * HROW + k * 2) = (bf16_t)(pk2(qi, 0.f) & 0xffff);
            *(LAS bf16_t*)(QA + t * HROW + k * 2) = (bf16_t)(pk2(qa, 0.f) & 0xffff);
            *(LAS bf16_t*)(KA + t * HROW + k * 2) = (bf16_t)(pk2(ka, 0.f) & 0xffff);
        }
    }
    __syncthreads();
    f32x16 acc;
#pragma unroll
    for (int i = 0; i < 16; ++i) acc[i] = 0.f;
    {
        const LAS unsigned char* qp = QI + (32 * tb + r) * HROW + 16 * h2;
#pragma unroll
        for (int ks = 0; ks < 8; ++ks) {
            const bf16x8 bq = *(const LAS bf16x8*)(qp + 32 * ks);
            const bf16x8 sa = *(const LAS bf16x8*)(SS + (32 * vb + r) * HROW + 16 * h2 + 32 * ks);
            acc = __builtin_amdgcn_mfma_f32_32x32x16_bf16(sa, bq, acc, 0, 0, 0);
        }
    }
    for (int sb = 0; sb <= tb; ++sb) {
        f32x16 AT;
#pragma unroll
        for (int i = 0; i < 16; ++i) AT[i] = 0.f;
        const LAS unsigned char* kp = KA + (32 * sb + r) * HROW + 16 * h2;
        const LAS unsigned char* qp = QA + (32 * tb + r) * HROW + 16 * h2;
#pragma unroll
        for (int ks = 0; ks < 8; ++ks) {
            const bf16x8 a = *(const LAS bf16x8*)(kp + 32 * ks);
            const bf16x8 bq = *(const LAS bf16x8*)(qp + 32 * ks);
            AT = __builtin_amdgcn_mfma_f32_32x32x16_bf16(a, bq, AT, 0, 0, 0);
        }
        if (sb == tb) {
#pragma unroll
            for (int i = 0; i < 16; ++i) { const int s = (i & 3) + 8 * (i >> 2) + 4 * h2; if (s > r) AT[i] = 0.f; }
        }
#pragma unroll
        for (int s2 = 0; s2 < 2; ++s2) {
            u32x4 w; w.x = pk2(AT[8 * s2 + 0], AT[8 * s2 + 1]); w.y = pk2(AT[8 * s2 + 2], AT[8 * s2 + 3]); w.z = pk2(AT[8 * s2 + 4], AT[8 * s2 + 5]); w.w = pk2(AT[8 * s2 + 6], AT[8 * s2 + 7]);
            const LAS unsigned char* vp = VTs + (32 * vb + r) * TROW + (32 * sb + 16 * s2 + 4 * h2) * 2;
            const u32x2 lo = *(const LAS u32x2*)vp, hi = *(const LAS u32x2*)(vp + 16);
            const u32x4 aw = {lo.x, lo.y, hi.x, hi.y};
            acc = __builtin_amdgcn_mfma_f32_32x32x16_bf16(__builtin_bit_cast(bf16x8, aw), __builtin_bit_cast(bf16x8, w), acc, 0, 0, 0);
        }
    }
    float ss = 0.f;
#pragma unroll
    for (int i = 0; i < 16; ++i) ss += acc[i] * acc[i];
    ss += __shfl_xor(ss, 32);
    if (h2 == 0) red[vb * 64 + tb * 32 + r] = ss;
    __syncthreads();
    {
        const int t = tb * 32 + r;
        const float tots = (red[t] + red[64 + t]) + (red[128 + t] + red[192 + t]);
        const float rs = rsqrtf(tots * (1.f / 128.f) + EPS_);
        LAS unsigned char* OB = QI;
#pragma unroll
        for (int g4 = 0; g4 < 4; ++g4) {
            const int v0 = 32 * vb + 8 * g4 + 4 * h2;
            const f32x4 o = {acc[4 * g4 + 0] * rs, acc[4 * g4 + 1] * rs, acc[4 * g4 + 2] * rs, acc[4 * g4 + 3] * rs};
            *(LAS u32x2*)(OB + t * HROW + v0 * 2) = pack4(o);
        }
    }
    __syncthreads();
#pragma unroll
    for (int j = 0; j < 2; ++j) {
        const int id = tid + 512 * j, t = id >> 4, c8 = (id & 15) * 8;
        const u32x4 ov = *(const LAS u32x4*)(QI + t * HROW + c8 * 2);
        const f32x4 n0 = *(const f32x4*)(ng + c8), n1 = *(const f32x4*)(ng + c8 + 4);
        const u32x4 z = gz[j];
        f32x4 o0, o1;
        o0[0] = bflo(ov.x) * n0[0] * siluf_(bflo(z.x)); o0[1] = bfhi(ov.x) * n0[1] * siluf_(bfhi(z.x));
        o0[2] = bflo(ov.y) * n0[2] * siluf_(bflo(z.y)); o0[3] = bfhi(ov.y) * n0[3] * siluf_(bfhi(z.y));
        o1[0] = bflo(ov.z) * n1[0] * siluf_(bflo(z.z)); o1[1] = bfhi(ov.z) * n1[1] * siluf_(bfhi(z.z));
        o1[2] = bflo(ov.w) * n1[2] * siluf_(bflo(z.w)); o1[3] = bfhi(ov.w) * n1[3] * siluf_(bfhi(z.w));
        *(u32x4*)(MIX2 + (size_t)(t0 + t) * DM + h * 128 + c8) = pack8(o0, o1);
    }
    __syncthreads();
}

constexpr int LDS_BYTES = 147456;
constexpr int NPH = 12;

__global__ void __launch_bounds__(512, 2) fwd_kernel(Args a) {
    extern __shared__ __attribute__((aligned(16))) unsigned char lds_raw[];
    LAS unsigned char* lds = (LAS unsigned char*)lds_raw;
    cg::grid_group grid = cg::this_grid();
    const int tid = threadIdx.x, lane = tid & 63, wave = __builtin_amdgcn_readfirstlane(tid >> 6);
    const int G = gridDim.x, bx = blockIdx.x;
    const int vcu = (G % 8 == 0) ? (bx % 8) * (G / 8) + bx / 8 : bx;
    unsigned char* ws = a.ws;
    const int lo = a.ph_lo, hi = a.ph_hi;
    if (a.flags & 128) grid.sync();
    volatile LAS unsigned* bst = (volatile LAS unsigned*)(lds + 131072 + 256);
    if (tid < 4) bst[tid] = 0u;
    __syncthreads();
    XcdBarrier bar = xcd_barrier_post((unsigned*)(ws + WS_BAR) + a.li * XCD_BAR_WORDS, bst);
#define IN(k) (lo <= (k) && (k) < hi)
#define SEAM(k) do { if (IN(k) && IN((k) + 1)) xcd_barrier(bar); } while (0)
    const float* x = a.in[0];
    float* rs0 = (float*)(ws + WS_RS0);
    float* lbv = (float*)(ws + WS_LB);
    float* ssq = (float*)(ws + WS_SSQ);
    float* ssq1 = (float*)(ws + WS_SSQ1);
    float* ropec = (float*)(ws + WS_ROPEC);
    float* ropes = (float*)(ws + WS_ROPES);
    bf16_t* PB = (bf16_t*)(ws + WS_PBUF);
    bf16_t* MIX = (bf16_t*)a.out;

    if (IN(0)) {
        LAS unsigned* scr = (LAS unsigned*)(lds + wave * 16384);
        const int gw = vcu * 8 + wave, NGW = G * 8;
        constexpr int I0 = 32 * 81, I1 = 8 * 24, I2 = 8 * 32;
        constexpr int NIT = I0 + I1 + I2;
#define P0_DESC(it_, d_) do { int r_ = (it_); \
            if (r_ < I0) { d_ = P0Desc{a.in[2], a.in[1], (bf16_t*)(ws + WS_WEVIN), 2048, EVIN, 81, 1, r_}; } else { r_ -= I0; \
            if (r_ < I1) { d_ = P0Desc{a.in[8], a.in[7], (bf16_t*)(ws + WS_WUQ), 512, 1536, 24, 2, r_}; } else { r_ -= I1; \
            d_ = P0Desc{a.in[10], a.in[9], (bf16_t*)(ws + WS_WUKV), 512, 2048, 32, 0, r_}; } } } while (0)
        {
            int it = gw;
            f32x4 va[16]; P0Desc da;
            if (it < NIT) { P0_DESC(it, da); p0_load(da, lane, va); }
            while (it < NIT) {
                const int nx = it + NGW;
                f32x4 vb[16]; P0Desc db = da;
                if (nx < NIT) { P0_DESC(nx, db); p0_load(db, lane, vb); }
                p0_store(da, lane, va, scr);
#pragma unroll
                for (int i = 0; i < 16; ++i) va[i] = vb[i];
                da = db; it = nx;
            }
        }
#undef P0_DESC
        { u32x4* z = (u32x4*)(ws + WS_WEVIN + (size_t)EVIN * 2048 * 2); const int nz = (EVIN_PAD - EVIN) * 2048 * 2 / 16;
          for (int i = bx * 512 + tid; i < nz; i += G * 512) z[i] = (u32x4){0u, 0u, 0u, 0u}; }
        bf16_t* XB = (bf16_t*)(ws + WS_XB);
        for (int m = gw; m < T_; m += NGW) {
            const f32x4* xr = (const f32x4*)(x + (size_t)m * DM) + lane;
            f32x4 v[8]; float s = 0.f;
#pragma unroll
            for (int j = 0; j < 8; ++j) { v[j] = xr[64 * j]; s += dot4(v[j]); }
            s = wave_sum(s);
            if (lane == 0) rs0[m] = rsqrtf(s * (1.f / 2048.f) + EPS_);
            u32x2* o8 = (u32x2*)(XB + (size_t)m * DM) + lane;
#pragma unroll
            for (int j = 0; j < 8; ++j) o8[64 * j] = pack4(v[j]);
        }
        for (int i = bx * 512 + tid; i < 2048; i += G * 512) { const float l0 = a.in[14][i], l1 = a.in[14][2048 + i]; lbv[i] = 1.f / (1.f + expf(l0 - l1)); }
        for (int i = bx * 512 + tid; i < SEQ * 32; i += G * 512) {
            const int pos = i >> 5, j = i & 31;
            const float inv = 1.0f / powf(10000.0f, (float)(2 * j) / 64.0f);
            const float ang = (float)pos * inv;
            ropec[i] = cosf(ang); ropes[i] = sinf(ang);
        }
    }
    SEAM(0);
    if (IN(1)) {
        pg8::Gemm g{(const bf16_t*)(ws + WS_XB), (const bf16_t*)(ws + WS_WEVIN), T_, EVIN_PAD, 2048, 2048, 2048};
        pg8::StaticOrder S; S.init(T_, EVIN_PAD, G, bx);
        {
            const int nunits = 32 * (EVIN_PAD / 256);
            const int nfull = nunits % G;
            const int nw = (nfull == 0) ? G : (G - nfull);
            const int wk = (nfull == 0) ? bx : (bx - nfull);
            if (wk >= 0) {
                LAS unsigned* scr = (LAS unsigned*)(lds + wave * 16384);
                constexpr int I3 = 32 * 32, I4 = 32 * 128, NIT = I3 + I4;
#define P1_DESC(it_, d_) do { int r_ = (it_); \
                if (r_ < I3) { d_ = P0Desc{a.in[11], nullptr, (bf16_t*)(ws + WS_WEVOUT), 2048, 2048, 32, 0, r_}; } else { r_ -= I3; \
                d_ = P0Desc{a.in[13], a.in[12], (bf16_t*)(ws + WS_WODIN), 2048, 8192, 128, 0, r_}; } } while (0)
                int it = wk * 8 + wave; const int NGW2 = nw * 8;
                f32x4 va[16]; P0Desc da;
                if (it < NIT) { P1_DESC(it, da); p0_load(da, lane, va); }
                while (it < NIT) {
                    const int nx = it + NGW2;
                    f32x4 vb[16]; P0Desc db = da;
                    if (nx < NIT) { P1_DESC(nx, db); p0_load(db, lane, vb); }
                    p0_store(da, lane, va, scr);
#pragma unroll
                    for (int i = 0; i < 16; ++i) va[i] = vb[i];
                    da = db; it = nx;
                }
#undef P1_DESC
            }
        }
        __syncthreads();
        EpiP1 E{PB, rs0, (bf16_t*)(ws + WS_KPE), ssq, ropec, ropes};
        pg8::gemm_phase<EpiP1, pg8::StaticOrder>(lds, g, S, E);
    }
    SEAM(1);
    if (IN(2)) {
        { pg8::Gemm g{PB + 3584, (const bf16_t*)(ws + WS_WUKV), T_, 2048, 512, LDP, 512};
          pg8::StaticOrder S; S.init(T_, 2048, G, bx);
          EpiKV E{(bf16_t*)(ws + WS_KN), (bf16_t*)(ws + WS_VT), ssq};
          pg8::gemm_phase<EpiKV, pg8::StaticOrder>(lds, g, S, E); }
        { pg8::Gemm g{PB + 3072, (const bf16_t*)(ws + WS_WUQ), T_, 1536, 512, LDP, 512};
          pg8::StaticOrder S; S.init(T_, 1536, G, (bx + 64) % G);
          EpiQ E{(bf16_t*)(ws + WS_QH), ssq};
          pg8::gemm_phase<EpiQ, pg8::StaticOrder>(lds, g, S, E); }
        { const int cq = (bx + 64) % G, nidle = G - 192;
          if (nidle >= 32 && cq >= 192) {
              LAS unsigned* scr = (LAS unsigned*)(lds + wave * 16384);
              for (int it = (cq - 192) * 8 + wave; it < 32 * 32; it += nidle * 8) {
                  f32x4 va[16]; P0Desc da = P0Desc{a.in[16], nullptr, (bf16_t*)(ws + WS_WODOUT), 2048, 2048, 32, 0, it};
                  p0_load(da, lane, va); p0_store(da, lane, va, scr);
              }
          } }
    }
    if (IN(3)) {
        __syncthreads();
        for (int it = bx; it < 512; it += G) conv_item(lds, it, PB, a.in[3], a.in[4], a.in[5], a.in[6], MIX);
        LAS unsigned* scr = (LAS unsigned*)(lds + wave * 16384);
        if (G - 192 < 32) for (int it = bx * 8 + wave; it < 32 * 32; it += G * 8) {
            f32x4 va[16]; P0Desc da = P0Desc{a.in[16], nullptr, (bf16_t*)(ws + WS_WODOUT), 2048, 2048, 32, 0, it};
            p0_load(da, lane, va); p0_store(da, lane, va, scr);
        }
    }
    SEAM(3);
    if (IN(4)) {
        for (int p = vcu; p < 256; p += G) {
            const int bh = p >> 4, i = p & 15;
            attn_item(lds, bh, 31 - i, (const bf16_t*)(ws + WS_QH), (const bf16_t*)(ws + WS_KN), (const bf16_t*)(ws + WS_KPE), (const bf16_t*)(ws + WS_VT), PB, MIX);
            attn_item(lds, bh, i, (const bf16_t*)(ws + WS_QH), (const bf16_t*)(ws + WS_KN), (const bf16_t*)(ws + WS_KPE), (const bf16_t*)(ws + WS_VT), PB, MIX);
        }
    }
    SEAM(4);
    if (IN(5)) {
        pg8::Gemm g{MIX, (const bf16_t*)(ws + WS_WEVOUT), T_, 2048, 2048, 2048, 2048};
        pg8::StaticOrder S; S.init(T_, 2048, G, bx);
        EpiRes1 E{(const bf16_t*)(ws + WS_XB), (bf16_t*)(ws + WS_X1B), ssq1};
        pg8::gemm_phase<EpiRes1, pg8::StaticOrder>(lds, g, S, E);
    }
    SEAM(5);
    if (IN(6)) {
        pg8::Gemm g{(const bf16_t*)(ws + WS_X1B), (const bf16_t*)(ws + WS_WODIN), T_, 8192, 2048, 2048, 2048};
        pg8::StaticOrder S; S.init(T_, 8192, G, bx);
        EpiHg E{ws, (bf16_t*)(ws + WS_LOGF), ssq1, lbv};
        pg8::gemm_phase<EpiHg, pg8::StaticOrder>(lds, g, S, E);
    }
    SEAM(6);
    if (IN(7)) {
        __syncthreads();
        int it = bx; unsigned lfa[16]; u32x4 iva[2];
        if (it < 2048) hgA_load(ws, it, lfa, iva);
        while (it < 2048) {
            const int nx = it + G; unsigned lfb[16]; u32x4 ivb[2];
#pragma unroll
            for (int i = 0; i < 16; ++i) lfb[i] = 0u;
            ivb[0] = iva[0]; ivb[1] = iva[1];
            if (nx < 2048) hgA_load(ws, nx, lfb, ivb);
            hgA_item(lds, ws, (unsigned char*)a.out, it, lfa, iva, lbv);
#pragma unroll
            for (int i = 0; i < 16; ++i) lfa[i] = lfb[i];
            iva[0] = ivb[0]; iva[1] = ivb[1]; it = nx;
        }
    }
    SEAM(7);
    if (IN(8)) hgB(ws, (unsigned char*)a.out, G, a.flags & 1);
    SEAM(8);
    if (IN(9)) {
        __syncthreads();
        int it = bx; unsigned lfa[16], qva[16]; u32x4 iva[2];
        if (it < 2048) hgC_load(ws, it, lfa, qva, iva);
        while (it < 2048) {
            const int nx = it + G; unsigned lfb[16], qvb[16]; u32x4 ivb[2];
#pragma unroll
            for (int i = 0; i < 16; ++i) { lfb[i] = 0u; qvb[i] = 0u; }
            ivb[0] = iva[0]; ivb[1] = iva[1];
            if (nx < 2048) hgC_load(ws, nx, lfb, qvb, ivb);
            hgC_item(lds, ws, (unsigned char*)a.out, it, a.in[15], a.flags & 2, lfa, qva, iva, lbv);
#pragma unroll
            for (int i = 0; i < 16; ++i) { lfa[i] = lfb[i]; qva[i] = qvb[i]; }
            iva[0] = ivb[0]; iva[1] = ivb[1]; it = nx;
        }
    }
    SEAM(9);
    if (IN(10)) {
        pg8::Gemm g{(const bf16_t*)(ws + WS_Q2), (const bf16_t*)(ws + WS_WODOUT), T_, 2048, 2048, 2048, 2048};
        pg8::StaticOrder S; S.init(T_, 2048, G, bx);
        if (G == 256) {
            EpiRes2N E{(const bf16_t*)(ws + WS_X1B), a.out, a.in[17], ssq, (unsigned*)(ws + WS_PCNT)};
            pg8::gemm_phase<EpiRes2N, pg8::StaticOrder>(lds, g, S, E);
        } else {
            EpiRes2 E{(const bf16_t*)(ws + WS_X1B), a.out};
            pg8::gemm_phase<EpiRes2, pg8::StaticOrder>(lds, g, S, E);
        }
    }
    if (G != 256) SEAM(10);
    if (IN(11) && G != 256) {
        const int gw = bx * 8 + wave, NGW = G * 8;
        const float* fg = a.in[17];
        for (int m = gw; m < T_; m += NGW) {
            f32x4* xr = (f32x4*)(a.out + (size_t)m * DM) + lane;
            f32x4 v[8]; float s = 0.f;
#pragma unroll
            for (int j = 0; j < 8; ++j) { v[j] = xr[64 * j]; s += dot4(v[j]); }
            s = wave_sum(s);
            const float rs = rsqrtf(s * (1.f / 2048.f) + EPS_);
#pragma unroll
            for (int j = 0; j < 8; ++j) { const f32x4 gg = *((const f32x4*)fg + lane + 64 * j); xr[64 * j] = v[j] * rs * gg; }
        }
    }
#undef IN
#undef SEAM
}


extern "C" void kernel_launch(void* const* d_in, const int* in_sizes, int n_in, void* d_out, int out_size, void* d_ws, size_t ws_size, hipStream_t stream) {
    static int grid = 0;
    if (grid == 0) {
        if (n_in != 18 || out_size != T_ * DM || ws_size < WS_NEED) { fprintf(stderr, "kernel_launch: unexpected shapes (n_in %d out %d ws %zu, need %zu)\n", n_in, out_size, ws_size, (size_t)WS_NEED); grid = -1; return; }
        int dev = 0, cus = 0, per_cu = 0;
        (void)hipGetDevice(&dev);
        (void)hipDeviceGetAttribute(&cus, hipDeviceAttributeMultiprocessorCount, dev);
        if (hipFuncSetAttribute((const void*)fwd_kernel, hipFuncAttributeMaxDynamicSharedMemorySize, LDS_BYTES) != hipSuccess) { fprintf(stderr, "kernel_launch: hipFuncSetAttribute failed\n"); grid = -1; return; }
        if (hipOccupancyMaxActiveBlocksPerMultiprocessor(&per_cu, (const void*)fwd_kernel, 512, LDS_BYTES) != hipSuccess || per_cu < 1) { fprintf(stderr, "kernel_launch: occupancy query says %d\n", per_cu); per_cu = 1; }
        (void)hipGetLastError();
        grid = cus * per_cu;
    }
    if (grid < 0) return;
    Args a{};
    for (int i = 0; i < 18; ++i) a.in[i] = (const float*)d_in[i];
    a.out = (float*)d_out; a.ws = (unsigned char*)d_ws;
#ifndef PROBE_PH
#define PROBE_PH -1
#endif
    if (hipMemsetAsync((char*)d_ws + WS_BAR, 0, 2 * XCD_BAR_WORDS * 4 + 32 * 64 * 4, stream) != hipSuccess) { fprintf(stderr, "kernel_launch: memset failed\n"); return; }
    const int nl = PROBE_PH >= 0 ? 2 : 1;
    const int los[2] = {0, PROBE_PH}, his[2] = {PROBE_PH >= 0 ? PROBE_PH + 1 : NPH, NPH};
    for (int li = 0; li < nl; ++li) {
        a.ph_lo = los[li]; a.ph_hi = his[li]; a.li = li; a.flags = (nl == 2 && li == 0) ? ((PROBE_PH == 8 ? 1 : 0) | (PROBE_PH == 9 ? 2 : 0)) : 0;
        void* args[] = {&a};
        hipError_t e = hipLaunchCooperativeKernel((const void*)fwd_kernel, dim3(grid), dim3(512), args, LDS_BYTES, stream);
        if (e != hipSuccess) fprintf(stderr, "cooperative launch failed: %s (grid %d)\n", hipGetErrorString(e), grid);
    }
}
```

```cpp
#include <hip/hip_runtime.h>
#include <hip/hip_cooperative_groups.h>
#include <cstdio>
#include <cstdint>
namespace cg = cooperative_groups;

#define LAS __attribute__((address_space(3)))
typedef unsigned short bf16_t;
typedef short bf16x8 __attribute__((ext_vector_type(8)));
typedef short s16x4 __attribute__((ext_vector_type(4)));
typedef float f32x4 __attribute__((ext_vector_type(4)));
typedef float f32x2 __attribute__((ext_vector_type(2)));
typedef float f32x16 __attribute__((ext_vector_type(16)));
typedef unsigned u32x4 __attribute__((ext_vector_type(4)));
typedef unsigned u32x2 __attribute__((ext_vector_type(2)));
typedef __bf16 bf2_t __attribute__((ext_vector_type(2)));

#define DI __device__ __forceinline__
typedef _Float16 h2_t __attribute__((ext_vector_type(2)));
DI unsigned pkh2(float lo, float hi) { f32x2 v = {lo, hi}; h2_t b = __builtin_convertvector(v, h2_t); return __builtin_bit_cast(unsigned, b); }
DI float h2f(unsigned short u) { return (float)__builtin_bit_cast(_Float16, u); }
DI unsigned pk2(float lo, float hi) { f32x2 v = {lo, hi}; bf2_t b = __builtin_convertvector(v, bf2_t); return __builtin_bit_cast(unsigned, b); }
DI float bf2f(unsigned short u) { return __builtin_bit_cast(float, (unsigned)u << 16); }
DI float bflo(unsigned u) { return __builtin_bit_cast(float, u << 16); }
DI float bfhi(unsigned u) { return __builtin_bit_cast(float, u & 0xffff0000u); }
DI float fexp2(float x) { return __builtin_amdgcn_exp2f(x); }
DI float fexp(float x) { return __builtin_amdgcn_exp2f(x * 1.4426950408889634f); }
DI float frcp(float x) { return __builtin_amdgcn_rcpf(x); }
DI float flog(float x) { return __builtin_amdgcn_logf(x) * 0.6931471805599453f; }
DI float sigmoidf_(float x) { return frcp(1.f + fexp(-x)); }
DI float siluf_(float x) { return x * frcp(1.f + fexp(-x)); }
DI float wave_sum(float v) {
#pragma unroll
    for (int o = 1; o < 64; o <<= 1) v += __shfl_xor(v, o);
    return v;
}

constexpr int T_ = 8192, SEQ = 4096, DM = 2048;
constexpr int EVIN = 5184, EVIN_PAD = 5376, LDP = 5184;
constexpr float EPS_ = 1e-6f;
constexpr float QSCALE = 0.07216878364870322f * 1.4426950408889634f;

constexpr size_t MiB = 1048576;
constexpr size_t WS_RS0 = 0;
constexpr size_t WS_LB = 64 * 1024;
constexpr size_t WS_SSQ = 128 * 1024;
constexpr size_t WS_BAR = 768 * 1024;
constexpr size_t WS_PCNT = WS_BAR + 2 * 3456 * 4;
constexpr size_t WS_SSQ1 = 1 * MiB;
constexpr size_t WS_ROPEC = 2 * MiB;
constexpr size_t WS_ROPES = 2 * MiB + 512 * 1024;
constexpr size_t WS_DEC = 3 * MiB;
constexpr size_t WS_WEVIN = 4 * MiB;
constexpr size_t WS_WUQ = 25 * MiB;
constexpr size_t WS_WUKV = WS_WUQ + 3 * MiB / 2;
constexpr size_t WS_WEVOUT = WS_WUKV + 2 * MiB;
constexpr size_t WS_WODIN = WS_WEVOUT + 8 * MiB;
constexpr size_t WS_WODOUT = WS_WODIN + 32 * MiB;
constexpr size_t WS_XB = WS_WODOUT + 8 * MiB;
constexpr size_t WS_MIX = WS_XB;
constexpr size_t WS_PBUF = WS_XB + 32 * MiB;
constexpr size_t WS_QH = WS_PBUF + 81 * MiB;
constexpr size_t WS_KN = WS_QH + 24 * MiB;
constexpr size_t WS_VT = WS_KN + 16 * MiB;
constexpr size_t WS_KPE = WS_VT + 16 * MiB;
constexpr size_t WS_END1 = WS_KPE + 1 * MiB;
constexpr size_t WS_X1B = WS_PBUF;
constexpr size_t WS_Q2 = WS_XB;
constexpr size_t WS_LOGF = WS_PBUF + 32 * MiB;
constexpr size_t WS_IV = WS_LOGF + 64 * MiB;
constexpr size_t WS_G2 = 4 * MiB;
constexpr size_t WS_DS0 = WS_WODIN;
constexpr size_t WS_DS1 = WS_X1B;
constexpr size_t WS_DUMMY = 237 * MiB;
constexpr size_t WS_NEED = 253 * MiB;
static_assert(WS_IV + 32 * MiB <= WS_NEED && WS_END1 <= WS_NEED, "ws map");
static_assert(WS_G2 + 32 * MiB <= WS_WODIN, "G2 overlaps ODIN");

namespace pg8 {
constexpr int BM = 256, BK = 64, HALF = 128, HTB = HALF * BK * 2, STAGE_BYTES = 8 * HTB, NXCD = 8, WGM = 8;
__host__ __device__ __forceinline__ int lds_byte(int r, int c) { const int st = (r >> 4) * 2 + (c >> 5), rr = r & 15, cc = c & 31, ob = rr * 64 + cc * 2; return st * 1024 + (ob ^ (((ob >> 9) & 1) << 5)); }
__host__ __device__ __forceinline__ void stage_rc(int b, int& R, int& C) { const int st = b / 1024, sb = b % 1024, swz = sb ^ (((sb >> 9) & 1) << 5); R = (st >> 1) * 16 + swz / 64; C = (st & 1) * 32 + (swz % 64) / 2; }
__host__ __device__ __forceinline__ int perm32(int rho) { const int n = rho >> 4, i = rho & 15; return 8 * (i >> 2) + 4 * n + (i & 3); }
struct Unit { int pm, pn; };
struct Gemm { const bf16_t* A; const bf16_t* Bt; int M, N, K, lda, ldb; };
struct StaticOrder {
    int nM, nN, nwg, G, c;
    __host__ __device__ void init(int M, int N, int G_, int c_) { nM = M / BM; nN = N / BM; nwg = nM * nN; G = G_; c = c_; }
    __host__ __device__ bool next(int i, Unit& u) const {
        const long L = (long)i * G + c; if (L >= nwg) return false;
        int wgid = (int)L; { const int q = nwg / NXCD, r = nwg % NXCD, xcd = wgid % NXCD, off = wgid / NXCD; wgid = (xcd < r ? xcd * (q + 1) : r * (q + 1) + (xcd - r) * q) + off; }
        const int nig = WGM * nN, gid = wgid / nig, fm = gid * WGM, gsz = (nM - fm) < WGM ? (nM - fm) : WGM;
        u.pm = fm + ((wgid % nig) % gsz); u.pn = (wgid % nig) / gsz; return true;
    }
};

template <class Epi, class Sched>
__device__ __forceinline__ void gemm_phase(LAS unsigned char* lds, const Gemm g, const Sched& S, const Epi& E) {
    const int tid = threadIdx.x, wid = __builtin_amdgcn_readfirstlane(tid >> 6), lane = tid & 63, wr = wid >> 2, wc = wid & 3, fr = lane & 15, fq = lane >> 4;
    const int K = g.K, nt = K / BK;
    unsigned voffA[2], voffB[2];
#pragma unroll
    for (int i = 0; i < 2; ++i) { int R, C; stage_rc(tid * 16 + i * 8192, R, C); const int Rb = Epi::PERM ? ((R & ~31) + perm32(R & 31)) : R;
        voffA[i] = (unsigned)(R * g.lda + C) * 2u; voffB[i] = (unsigned)(Rb * g.ldb + C) * 2u; }
    const size_t kstep = (size_t)(BK * 2);
    const size_t hsA = (size_t)HALF * g.lda * 2, hsB = (size_t)HALF * g.ldb * 2;
    const size_t tsA = 2 * hsA, tsB = 2 * hsB;
    const unsigned ldsw = (unsigned)wid * 1024u;
    const int aoff = lds_byte(wr * 64 + fr, fq * 8), boff = lds_byte(wc * 32 + fr, fq * 8);
#define PG8_SA(b, h) (((b) * 2 + (h)) * HTB)
#define PG8_SB(b, h) ((4 + (b) * 2 + (h)) * HTB)
#define PG8_STAGE(bufoff, gbase, voff) do { _Pragma("unroll") for (int _i = 0; _i < 2; ++_i) \
        __builtin_amdgcn_global_load_lds((const unsigned*)((const char*)(gbase) + (voff)[_i]), (LAS unsigned*)(lds + (bufoff) + ldsw + _i * 8192), 16, 0, 0); } while (0)
#define PG8_LDA(dst, b, h) do { _Pragma("unroll") for (int m = 0; m < 4; ++m) _Pragma("unroll") for (int k = 0; k < 2; ++k) dst[m][k] = *(const LAS bf16x8*)(lds + PG8_SA(b, h) + aoff + m * 2048 + k * 1024); } while (0)
#define PG8_LDB(dst, b, h) do { _Pragma("unroll") for (int n = 0; n < 2; ++n) _Pragma("unroll") for (int k = 0; k < 2; ++k) dst[n][k] = *(const LAS bf16x8*)(lds + PG8_SB(b, h) + boff + n * 2048 + k * 1024); } while (0)
#define PG8_MMA(ai, bj, At, Bt) do { __builtin_amdgcn_s_setprio(1); _Pragma("unroll") for (int m = 0; m < 4; ++m) _Pragma("unroll") for (int n = 0; n < 2; ++n) _Pragma("unroll") for (int k = 0; k < 2; ++k) \
        acc[ai][bj][m][n] = __builtin_amdgcn_mfma_f32_16x16x32_bf16(Bt[n][k], At[m][k], acc[ai][bj][m][n], 0, 0, 0); __builtin_amdgcn_s_setprio(0); } while (0)
#define PG8_WAIT_V(n) asm volatile("s_waitcnt vmcnt(" #n ")" ::: "memory")
#define PG8_WAIT_L(n) asm volatile("s_waitcnt lgkmcnt(" #n ")" ::: "memory")
#define PG8_BAR __builtin_amdgcn_s_barrier()
#define PG8_SCHED __builtin_amdgcn_sched_barrier(0)
    Unit cur, nxt; int ui = 0;
    if (!S.next(0, cur)) return;
    f32x4 acc[2][2][4][2];
#pragma unroll
    for (int a = 0; a < 2; ++a)
#pragma unroll
        for (int b = 0; b < 2; ++b)
#pragma unroll
            for (int m = 0; m < 4; ++m)
#pragma unroll
                for (int n = 0; n < 2; ++n) acc[a][b][m][n] = (f32x4){0.f, 0.f, 0.f, 0.f};
    bf16x8 At[4][2], B0[2][2], B1[2][2];
    const char* cA = (const char*)g.A + (size_t)cur.pm * tsA; const char* cB = (const char*)g.Bt + (size_t)cur.pn * tsB;
    PG8_STAGE(PG8_SB(0, 0), cB, voffB); PG8_STAGE(PG8_SB(0, 1), cB + hsB, voffB); PG8_STAGE(PG8_SA(0, 0), cA, voffA); PG8_STAGE(PG8_SA(0, 1), cA + hsA, voffA);
    if (wr == 1) PG8_BAR;
    PG8_WAIT_V(2); PG8_BAR;
    PG8_STAGE(PG8_SB(1, 0), cB + kstep, voffB); PG8_STAGE(PG8_SA(1, 0), cA + kstep, voffA); PG8_STAGE(PG8_SB(1, 1), cB + hsB + kstep, voffB);
    PG8_WAIT_V(6); PG8_BAR;
    for (;;) {
        float pre[8];
        if constexpr (Epi::PRE) E.pre_load(cur, wr, fr, pre);
        const bool has_next = S.next(ui + 1, nxt);
        const char* nA = has_next ? (const char*)g.A + (size_t)nxt.pm * tsA : cA; const char* nB = has_next ? (const char*)g.Bt + (size_t)nxt.pn * tsB : cB;
        for (int t = 0; t < nt; t += 2) {
            const bool last = (t == nt - 2);
            const char* a1 = cA + (size_t)(t + 1) * kstep;
            const char* a2 = last ? nA : cA + (size_t)(t + 2) * kstep; const char* b2 = last ? nB : cB + (size_t)(t + 2) * kstep;
            const char* a3 = a2 + kstep; const char* b3 = b2 + kstep;
            PG8_LDB(B0, 0, 0); PG8_LDB(B1, 0, 1); PG8_SCHED; PG8_LDA(At, 0, 0); PG8_STAGE(PG8_SA(1, 1), a1 + hsA, voffA);
            PG8_WAIT_V(8); PG8_WAIT_L(0); PG8_BAR; PG8_MMA(0, 0, At, B0); PG8_MMA(0, 1, At, B1); PG8_BAR; PG8_SCHED;
            PG8_LDA(At, 0, 1); PG8_STAGE(PG8_SB(0, 0), b2, voffB); PG8_STAGE(PG8_SB(0, 1), b2 + hsB, voffB); PG8_STAGE(PG8_SA(0, 0), a2, voffA);
            PG8_WAIT_V(8); PG8_WAIT_L(0); PG8_BAR; PG8_MMA(1, 0, At, B0); PG8_MMA(1, 1, At, B1); PG8_BAR; PG8_SCHED;
            PG8_LDB(B0, 1, 0); PG8_LDB(B1, 1, 1); PG8_SCHED; PG8_LDA(At, 1, 0); PG8_STAGE(PG8_SA(0, 1), a2 + hsA, voffA);
            PG8_WAIT_V(8); PG8_WAIT_L(0); PG8_BAR; PG8_MMA(0, 0, At, B0); PG8_MMA(0, 1, At, B1); PG8_BAR; PG8_SCHED;
            PG8_LDA(At, 1, 1); PG8_STAGE(PG8_SB(1, 0), b3, voffB); PG8_STAGE(PG8_SB(1, 1), b3 + hsB, voffB); PG8_STAGE(PG8_SA(1, 0), a3, voffA);
            PG8_WAIT_V(8); PG8_WAIT_L(0); PG8_BAR; PG8_MMA(1, 0, At, B0); PG8_MMA(1, 1, At, B1); PG8_BAR; PG8_SCHED;
        }
        if (wr == 0) PG8_BAR;
        if constexpr (Epi::PRE) E.with_pre(acc, cur, wr, wc, fr, fq, pre);
        else if constexpr (!Epi::AFTER_DRAIN) E(acc, cur, wr, wc, fr, fq);
        if (!has_next) break;
#pragma unroll
        for (int a = 0; a < 2; ++a)
#pragma unroll
            for (int b = 0; b < 2; ++b)
#pragma unroll
                for (int m = 0; m < 4; ++m)
#pragma unroll
                    for (int n = 0; n < 2; ++n) acc[a][b][m][n] = (f32x4){0.f, 0.f, 0.f, 0.f};
        cur = nxt; cA = nA; cB = nB; ++ui;
        if (wr == 1) PG8_BAR;
    }
    PG8_WAIT_V(0);
    PG8_BAR;
    if constexpr (Epi::AFTER_DRAIN) E.fused(acc, cur, wr, wc, fr, fq, lds, wid, lane);
#undef PG8_SA
#undef PG8_SB
#undef PG8_STAGE
#undef PG8_LDA
#undef PG8_LDB
#undef PG8_MMA
#undef PG8_WAIT_V
#undef PG8_WAIT_L
#undef PG8_BAR
#undef PG8_SCHED
}
}
using pg8::Unit;

DI u32x4 pack8(const f32x4 a, const f32x4 b) { u32x4 w; w.x = pk2(a[0], a[1]); w.y = pk2(a[2], a[3]); w.z = pk2(b[0], b[1]); w.w = pk2(b[2], b[3]); return w; }
DI u32x2 pack4(const f32x4 a) { u32x2 w; w.x = pk2(a[0], a[1]); w.y = pk2(a[2], a[3]); return w; }
DI float dot4(const f32x4 a) { return (a[0] * a[0] + a[1] * a[1]) + (a[2] * a[2] + a[3] * a[3]); }

#define EPI_FENCE() asm volatile("" ::: "memory")
struct EpiP1 {
    static constexpr bool PRE = true;
    DI void pre_load(const Unit& u, int wr, int fr, float (&pre)[8]) const {
        const int rbase = u.pm * 256 + wr * 64 + fr;
#pragma unroll
        for (int i = 0; i < 8; ++i) pre[i] = rs0[rbase + (i >> 2) * 128 + (i & 3) * 16];
    }
    static constexpr bool AFTER_DRAIN = false;
    static constexpr bool PERM = true;
    bf16_t* P; const float* rs0; bf16_t* kpe; float* ssq; const float* rc; const float* rsn;
    DI void with_pre(const f32x4 (&acc)[2][2][4][2], const Unit& u, int wr, int wc, int fr, int fq, const float (&rsv)[8]) const {
        const int colt = u.pn * 256;
        const bool do_ssq = (u.pn >= 12 && u.pn < 16);
        const int rbase = u.pm * 256 + wr * 64 + fr;
        const bool rope_tile = (u.pn == 16);
        const int c00 = colt + wc * 32 + 8 * fq;
        const bool rope_lane = rope_tile && (c00 < 4160);
        f32x4 cv[8], sv[8];
        if (rope_lane) {
            const int i0 = ((c00 - 4096) >> 3) * 4;
#pragma unroll
            for (int i = 0; i < 8; ++i) { const int pos = (rbase + (i >> 2) * 128 + (i & 3) * 16) & (SEQ - 1); cv[i] = *(const f32x4*)(rc + pos * 32 + i0); sv[i] = *(const f32x4*)(rsn + pos * 32 + i0); }
        }
        EPI_FENCE();
#pragma unroll
        for (int ai = 0; ai < 2; ++ai)
#pragma unroll
            for (int m = 0; m < 4; ++m) {
                const int r = rbase + ai * 128 + m * 16;
                const float rs = rsv[ai * 4 + m];
                float ss = 0.f;
#pragma unroll
                for (int bj = 0; bj < 2; ++bj) {
                    const int c0 = c00 + bj * 128;
                    const f32x4 v0 = acc[ai][bj][m][0] * rs, v1 = acc[ai][bj][m][1] * rs;
                    if (bj == 0 && rope_lane) {
                        const int i0 = ((c0 - 4096) >> 3) * 4;
                        const f32x4 c = cv[ai * 4 + m], sn = sv[ai * 4 + m];
                        const f32x4 o1 = v0 * c - v1 * sn, o2 = v0 * sn + v1 * c;
                        *(u32x2*)(kpe + (size_t)r * 64 + i0) = pack4(o1);
                        *(u32x2*)(kpe + (size_t)r * 64 + 32 + i0) = pack4(o2);
                    } else if (c0 < EVIN) {
                        *(u32x4*)(P + (size_t)r * LDP + c0) = pack8(v0, v1);
                        ss += dot4(v0) + dot4(v1);
                    }
                }
                if (do_ssq) { ss += __shfl_xor(ss, 16); ss += __shfl_xor(ss, 32); if (fq == 0) ssq[(size_t)r * 16 + (u.pn - 12) * 4 + wc] = ss; }
            }
    }
};
DI float ssq8(const float* p) { const f32x4 a = *(const f32x4*)p, b = *(const f32x4*)(p + 4); return ((a[0] + a[1]) + (a[2] + a[3])) + ((b[0] + b[1]) + (b[2] + b[3])); }
struct EpiQ {
    static constexpr bool PRE = false;
    static constexpr bool AFTER_DRAIN = false;
    static constexpr bool PERM = true;
    bf16_t* QH; const float* ssq;
    DI void operator()(const f32x4 (&acc)[2][2][4][2], const Unit& u, int wr, int wc, int fr, int fq) const {
        const int colt = u.pn * 256;
        const int rbase = u.pm * 256 + wr * 64 + fr;
        float rsv[8];
#pragma unroll
        for (int i = 0; i < 8; ++i) { const f32x2 t2 = *(const f32x2*)(ssq + (size_t)(rbase + (i >> 2) * 128 + (i & 3) * 16) * 16 + 2 * fq); rsv[i] = t2[0] + t2[1]; }
#pragma unroll
        for (int i = 0; i < 8; ++i) { float sq = rsv[i]; sq += __shfl_xor(sq, 16); sq += __shfl_xor(sq, 32); rsv[i] = rsqrtf(sq * (1.f / 512.f) + EPS_) * QSCALE; }
        EPI_FENCE();
#pragma unroll
        for (int bj = 0; bj < 2; ++bj) {
            const int c0 = colt + bj * 128 + wc * 32 + 8 * fq;
            const int h = c0 / 192, d0 = c0 - h * 192;
            const bool rope = d0 >= 128;
            const int i0 = rope ? ((d0 - 128) >> 3) * 4 : 0;
            f32x4 fr4;
#pragma unroll
            for (int e = 0; e < 4; ++e) fr4[e] = fexp2(-(float)(i0 + e) * (13.287712379549449f / 32.f)) * 0.15915494309189535f;
#pragma unroll
            for (int ai = 0; ai < 2; ++ai)
#pragma unroll
                for (int m = 0; m < 4; ++m) {
                    const int r = rbase + ai * 128 + m * 16;
                    const float rs = rsv[ai * 4 + m];
                    const int b = r >> 12, s = r & (SEQ - 1);
                    bf16_t* base = QH + ((size_t)(b * 8 + h) * SEQ + s) * 192;
                    const f32x4 v0 = acc[ai][bj][m][0] * rs, v1 = acc[ai][bj][m][1] * rs;
                    if (!rope) *(u32x4*)(base + d0) = pack8(v0, v1);
                    else {
                        f32x4 c, sn;
#pragma unroll
                        for (int e = 0; e < 4; ++e) { const float rev = (float)s * fr4[e]; const float fr_ = rev - floorf(rev); c[e] = __builtin_amdgcn_cosf(fr_); sn[e] = __builtin_amdgcn_sinf(fr_); }
                        const f32x4 o1 = v0 * c - v1 * sn, o2 = v0 * sn + v1 * c;
                        *(u32x2*)(base + 128 + i0) = pack4(o1);
                        *(u32x2*)(base + 160 + i0) = pack4(o2);
                    }
                }
        }
    }
};
struct EpiKV {
    static constexpr bool PRE = false;
    static constexpr bool AFTER_DRAIN = false;
    static constexpr bool PERM = true;
    bf16_t* KN; bf16_t* VT; const float* ssq;
    DI void operator()(const f32x4 (&acc)[2][2][4][2], const Unit& u, int wr, int wc, int fr, int fq) const {
        const int h = u.pn;
        const int rbase = u.pm * 256 + wr * 64 + fr;
        float rsv[8];
#pragma unroll
        for (int i = 0; i < 8; ++i) { const f32x2 t2 = *(const f32x2*)(ssq + (size_t)(rbase + (i >> 2) * 128 + (i & 3) * 16) * 16 + 8 + 2 * fq); rsv[i] = t2[0] + t2[1]; }
#pragma unroll
        for (int i = 0; i < 8; ++i) { float sq = rsv[i]; sq += __shfl_xor(sq, 16); sq += __shfl_xor(sq, 32); rsv[i] = rsqrtf(sq * (1.f / 512.f) + EPS_); }
        EPI_FENCE();
#pragma unroll
        for (int ai = 0; ai < 2; ++ai)
#pragma unroll
            for (int m = 0; m < 4; ++m) {
                const int r = rbase + ai * 128 + m * 16;
                const float rs = rsv[ai * 4 + m];
                const int b = r >> 12, s = r & (SEQ - 1);
                const int d = wc * 32 + 8 * fq;
                *(u32x4*)(KN + ((size_t)(b * 8 + h) * SEQ + s) * 128 + d) = pack8(acc[ai][0][m][0] * rs, acc[ai][0][m][1] * rs);
                *(u32x4*)(VT + ((size_t)(b * 8 + h) * SEQ + s) * 128 + d) = pack8(acc[ai][1][m][0] * rs, acc[ai][1][m][1] * rs);
            }
    }
};
struct EpiRes1 {
    static constexpr bool PRE = false;
    static constexpr bool AFTER_DRAIN = false;
    static constexpr bool PERM = true;
    const bf16_t* base; bf16_t* xb; float* ssq;
    DI void operator()(const f32x4 (&acc)[2][2][4][2], const Unit& u, int wr, int wc, int fr, int fq) const {
        const int col0 = u.pn * 256 + wc * 32 + 8 * fq;
        const int rbase = u.pm * 256 + wr * 64 + fr;
        u32x4 xw[8][2];
#pragma unroll
        for (int i = 0; i < 8; ++i)
#pragma unroll
            for (int bj = 0; bj < 2; ++bj) xw[i][bj] = *(const u32x4*)(base + (size_t)(rbase + (i >> 2) * 128 + (i & 3) * 16) * DM + col0 + bj * 128);
        EPI_FENCE();
#pragma unroll
        for (int ai = 0; ai < 2; ++ai)
#pragma unroll
            for (int m = 0; m < 4; ++m) {
                const int r = rbase + ai * 128 + m * 16;
                const size_t off = (size_t)r * DM + col0;
                float ss = 0.f;
#pragma unroll
                for (int bj = 0; bj < 2; ++bj) {
                    const u32x4 w = xw[ai * 4 + m][bj];
                    const f32x4 v0 = (f32x4){bflo(w.x), bfhi(w.x), bflo(w.y), bfhi(w.y)} + acc[ai][bj][m][0];
                    const f32x4 v1 = (f32x4){bflo(w.z), bfhi(w.z), bflo(w.w), bfhi(w.w)} + acc[ai][bj][m][1];
                    *(u32x4*)(xb + off + bj * 128) = pack8(v0, v1); ss += dot4(v0) + dot4(v1);
                }
                ss += __shfl_xor(ss, 16); ss += __shfl_xor(ss, 32); if (fq == 0) ssq[(size_t)r * 32 + u.pn * 4 + wc] = ss;
            }
    }
};
struct EpiRes2 {
    static constexpr bool PRE = false;
    static constexpr bool AFTER_DRAIN = false;
    static constexpr bool PERM = false;
    const bf16_t* xb; float* out;
    DI void operator()(const f32x4 (&acc)[2][2][4][2], const Unit& u, int wr, int wc, int fr, int fq) const {
        const int col0 = u.pn * 256 + wc * 32 + 4 * fq;
#pragma unroll
        for (int ai = 0; ai < 2; ++ai)
#pragma unroll
            for (int m = 0; m < 4; ++m) {
                const int r = u.pm * 256 + ai * 128 + wr * 64 + m * 16 + fr;
                const size_t off = (size_t)r * DM + col0;
#pragma unroll
                for (int bj = 0; bj < 2; ++bj)
#pragma unroll
                    for (int n = 0; n < 2; ++n) {
                        const u32x2 w = *(const u32x2*)(xb + off + bj * 128 + n * 16);
                        const f32x4 b4 = {bflo(w.x), bfhi(w.x), bflo(w.y), bfhi(w.y)};
                        *(f32x4*)(out + off + bj * 128 + n * 16) = b4 + acc[ai][bj][m][n];
                    }
            }
    }
};

struct EpiRes2N {
    static constexpr bool PRE = false;
    static constexpr bool PERM = true, AFTER_DRAIN = true;
    const bf16_t* xb; float* out; const float* fg; float* part; unsigned* cnt;
    DI void fused(f32x4 (&acc)[2][2][4][2], const Unit& u, int wr, int wc, int fr, int fq, LAS unsigned char* lds, int wid, int lane) const {
        LAS float* P = (LAS float*)lds;
        LAS float* R = (LAS float*)(lds + 4096);
        const int col0 = u.pn * 256 + wc * 32 + 8 * fq;
#pragma unroll
        for (int ai = 0; ai < 2; ++ai)
#pragma unroll
            for (int m = 0; m < 4; ++m) {
                const int rl = ai * 128 + wr * 64 + m * 16 + fr;
                const size_t off = (size_t)(u.pm * 256 + rl) * DM + col0;
                float ss = 0.f;
#pragma unroll
                for (int bj = 0; bj < 2; ++bj) {
                    const u32x4 w = *(const u32x4*)(xb + off + bj * 128);
                    acc[ai][bj][m][0] += (f32x4){bflo(w.x), bfhi(w.x), bflo(w.y), bfhi(w.y)};
                    acc[ai][bj][m][1] += (f32x4){bflo(w.z), bfhi(w.z), bflo(w.w), bfhi(w.w)};
                    ss += dot4(acc[ai][bj][m][0]) + dot4(acc[ai][bj][m][1]);
                }
                ss += __shfl_xor(ss, 16); ss += __shfl_xor(ss, 32);
                if (fq == 0) P[rl * 4 + wc] = ss;
            }
        __syncthreads();
        const int tid = wid * 64 + lane;
        if (tid < 256) {
            const f32x4 p4 = *(LAS f32x4*)(P + tid * 4);
            __hip_atomic_store(part + (size_t)(u.pm * 256 + tid) * 8 + u.pn, (p4[0] + p4[1]) + (p4[2] + p4[3]), __ATOMIC_RELAXED, __HIP_MEMORY_SCOPE_AGENT);
        }
        asm volatile("s_waitcnt vmcnt(0)" ::: "memory");
        __syncthreads();
        if (tid == 0) {
            __builtin_amdgcn_fence(__ATOMIC_RELEASE, "agent");
            __hip_atomic_fetch_add(cnt + 64 * u.pm, 1u, __ATOMIC_RELAXED, __HIP_MEMORY_SCOPE_AGENT);
            unsigned sp = 0;
            while (__hip_atomic_load(cnt + 64 * u.pm, __ATOMIC_RELAXED, __HIP_MEMORY_SCOPE_AGENT) < 8u) { __builtin_amdgcn_s_sleep(1); if (++sp > (1u << 22)) break; }
            __builtin_amdgcn_fence(__ATOMIC_ACQUIRE, "agent");
        }
        __syncthreads();
        if (tid < 256) {
            const float* pp = part + (size_t)(u.pm * 256 + tid) * 8;
            float s = 0.f;
#pragma unroll
            for (int j = 0; j < 8; ++j) s += __hip_atomic_load(pp + j, __ATOMIC_RELAXED, __HIP_MEMORY_SCOPE_AGENT);
            R[tid] = rsqrtf(s * (1.f / 2048.f) + EPS_);
        }
        __syncthreads();
        f32x4 gv[2][2];
#pragma unroll
        for (int bj = 0; bj < 2; ++bj)
#pragma unroll
            for (int n = 0; n < 2; ++n) gv[bj][n] = *(const f32x4*)(fg + col0 + bj * 128 + n * 4);
#pragma unroll
        for (int ai = 0; ai < 2; ++ai)
#pragma unroll
            for (int m = 0; m < 4; ++m) {
                const int rl = ai * 128 + wr * 64 + m * 16 + fr;
                const float rs = R[rl];
                const size_t off = (size_t)(u.pm * 256 + rl) * DM + col0;
#pragma unroll
                for (int bj = 0; bj < 2; ++bj)
#pragma unroll
                    for (int n = 0; n < 2; ++n) *(f32x4*)(out + off + bj * 128 + n * 4) = acc[ai][bj][m][n] * rs * gv[bj][n];
            }
    }
};
struct EpiHg {
    static constexpr bool PRE = false;
    static constexpr bool AFTER_DRAIN = false;
    static constexpr bool PERM = true;
    unsigned char* ws; bf16_t* LOGF; const float* ssq; const float* lb;
    DI void operator()(const f32x4 (&acc)[2][2][4][2], const Unit& u, int wr, int wc, int fr, int fq) const {
        const int seg = u.pn >> 3, colt = (u.pn & 7) * 256;
        const size_t dsto = (size_t)(seg == 0) * WS_Q2 + (size_t)(seg == 2) * WS_IV + (size_t)(seg == 3) * WS_G2;
        bf16_t* dst = (bf16_t*)(ws + dsto);
        const int rbase = u.pm * 256 + wr * 64 + fr;
        float rsv[8];
#pragma unroll
        for (int i = 0; i < 8; ++i) rsv[i] = ssq8(ssq + (size_t)(rbase + (i >> 2) * 128 + (i & 3) * 16) * 32 + 8 * fq);
#pragma unroll
        for (int i = 0; i < 8; ++i) { float sq = rsv[i]; sq += __shfl_xor(sq, 16); sq += __shfl_xor(sq, 32); rsv[i] = rsqrtf(sq * (1.f / 2048.f) + EPS_); }
        EPI_FENCE();
#pragma unroll
        for (int ai = 0; ai < 2; ++ai)
#pragma unroll
            for (int m = 0; m < 4; ++m) {
                const int r = rbase + ai * 128 + m * 16;
                const float rs = rsv[ai * 4 + m];
#pragma unroll
                for (int bj = 0; bj < 2; ++bj) {
                    const int cc = colt + bj * 128 + wc * 32 + 8 * fq;
                    const f32x4 v0 = acc[ai][bj][m][0] * rs, v1 = acc[ai][bj][m][1] * rs;
                    const size_t off = (size_t)r * DM + cc;
                    if (seg == 2) {
                        const int bb = r >> 12, tt = r & (SEQ - 1), ch = tt >> 6, sl = tt & 63, hh = cc >> 7, vv0 = cc & 127;
                        bf16_t* vb = dst + ((size_t)(((bb * 16 + hh) * 64 + ch) * 128 + vv0)) * 64 + sl;
                        const u32x4 w = pack8(v0, v1);
                        vb[0 * 64] = (bf16_t)(w.x & 0xffff); vb[1 * 64] = (bf16_t)(w.x >> 16);
                        vb[2 * 64] = (bf16_t)(w.y & 0xffff); vb[3 * 64] = (bf16_t)(w.y >> 16);
                        vb[4 * 64] = (bf16_t)(w.z & 0xffff); vb[5 * 64] = (bf16_t)(w.z >> 16);
                        vb[6 * 64] = (bf16_t)(w.w & 0xffff); vb[7 * 64] = (bf16_t)(w.w >> 16);
                    } else if (seg == 1) {
                        u32x4 w; w.x = pkh2(v0[0], v0[1]); w.y = pkh2(v0[2], v0[3]); w.z = pkh2(v1[0], v1[1]); w.w = pkh2(v1[2], v1[3]);
                        *(u32x4*)(LOGF + off) = w;
                    } else {
                        *(u32x4*)(dst + off) = pack8(v0, v1);
                    }
                }
            }
    }
};

#define XB_TMO      128
#define XB_XCNT(j)  (256  + 64 * (j))
#define XB_XSUB(j)  (1280 + 64 * (j))
#define XB_XGEN(j)  (2304 + 64 * (j))
#define XB_TOP      3328
#define XB_TOPGEN   3392
#define XCD_BAR_WORDS 3456
#define XB_SPIN_CAP (1u << 18)
DI unsigned xb_ld(unsigned* p)              { return __hip_atomic_load(p, __ATOMIC_RELAXED, __HIP_MEMORY_SCOPE_AGENT); }
DI unsigned xb_add(unsigned* p, unsigned v) { return __hip_atomic_fetch_add(p, v, __ATOMIC_RELAXED, __HIP_MEMORY_SCOPE_AGENT); }
DI unsigned xb_xcc_id() { return (unsigned)__builtin_amdgcn_s_getreg((3 << 11) | 20) & 0xFu; }
#define XB_SPIN(cond, bar) do { unsigned _sp = 0; while (cond) { __builtin_amdgcn_s_sleep(1); \
    if ((++_sp & 255u) == 0u) { if (xb_ld(&(bar)[XB_TMO])) break; if (_sp > XB_SPIN_CAP) { atomicAdd(&(bar)[XB_TMO], 1u); break; } } } } while (0)
struct XcdBarrier { unsigned* bar; unsigned x; volatile LAS unsigned* st; };
DI XcdBarrier xcd_barrier_post(unsigned* bar, volatile LAS unsigned* st) {
    XcdBarrier b; b.bar = bar; b.x = xb_xcc_id(); b.st = st;
    if (threadIdx.x == 0) (void)xb_add(&bar[XB_XCNT(b.x)], 1u);
    return b;
}
DI void xcd_barrier_complete(unsigned* bar, unsigned x, unsigned& nloc, unsigned& nx) {
    const unsigned G = gridDim.x * gridDim.y * gridDim.z;
    unsigned sum, cnt, mine, sp = 0u;
    for (;;) {
        sum = 0u; cnt = 0u; mine = 0u;
#pragma unroll
        for (unsigned j = 0; j < 16; ++j) { const unsigned c = xb_ld(&bar[XB_XCNT(j)]); sum += c; cnt += (c > 0u) ? 1u : 0u; mine = (j == x) ? c : mine; }
        if (sum == G) break;
        __builtin_amdgcn_s_sleep(1);
        if ((++sp & 255u) == 0u) { if (xb_ld(&bar[XB_TMO])) break; if (sp > XB_SPIN_CAP) { atomicAdd(&bar[XB_TMO], 1u); break; } }
    }
    nloc = mine > 0u ? mine : 1u; nx = cnt > 0u ? cnt : 1u;
}
DI void xcd_barrier(const XcdBarrier& b) {
    asm volatile("s_waitcnt vmcnt(0)" ::: "memory");
    __syncthreads();
    if (threadIdx.x == 0) {
        unsigned* bar = b.bar;
        __builtin_amdgcn_s_waitcnt(0);
        unsigned nloc = b.st[0], nx = b.st[1];
        if (nloc == 0u) { xcd_barrier_complete(bar, b.x, nloc, nx); b.st[0] = nloc; b.st[1] = nx; }
        const unsigned old = xb_add(&bar[XB_XSUB(b.x)], 1u);
        const unsigned gen = old / nloc;
        if (old + 1u == (gen + 1u) * nloc) {
            __builtin_amdgcn_fence(__ATOMIC_RELEASE, "agent");
            asm volatile("s_waitcnt vmcnt(0)" ::: "memory");
            const unsigned og = xb_add(&bar[XB_TOP], 1u);
            const unsigned tg = og / nx;
            if (og + 1u == (tg + 1u) * nx) xb_add(&bar[XB_TOPGEN], 1u);
            else XB_SPIN(xb_ld(&bar[XB_TOPGEN]) == tg, bar);
            __builtin_amdgcn_fence(__ATOMIC_ACQUIRE, "agent");
            xb_add(&bar[XB_XGEN(b.x)], 1u);
            asm volatile("s_waitcnt vmcnt(0)" ::: "memory");
        } else {
            XB_SPIN(xb_ld(&bar[XB_XGEN(b.x)]) == gen, bar);
            __builtin_amdgcn_fence(__ATOMIC_ACQUIRE, "agent");
            asm volatile("s_waitcnt vmcnt(0)" ::: "memory");
        }
    }
    __syncthreads();
}

struct Args {
    const float* in[18];
    float* out; unsigned char* ws;
    int ph_lo, ph_hi, flags, li;
};

template <int MAP> DI int map_row(int n) {
    if (MAP == 1) {
        if (n >= 4096 && n < 4160) { const int d = n - 4096, i = d & 31, hi = d >> 5; return 4096 + 8 * (i >> 2) + 4 * hi + (i & 3); }
        return n;
    }
    if (MAP == 2) {
        const int h = n / 192, d = n - h * 192;
        if (d >= 128) { const int dd = d - 128, i = dd & 31, hi = dd >> 5; return h * 192 + 128 + 8 * (i >> 2) + 4 * hi + (i & 3); }
        return n;
    }
    return n;
}
struct P0Desc { const float* W; const float* gain; bf16_t* WT; int K, N, nblk, map, item; };
DI void p0_load(const P0Desc& d, int lane, f32x4 (&v)[16]) {
    const int kb = d.item / d.nblk, nb = d.item - kb * d.nblk;
    const float* p = d.W + (size_t)(64 * kb + 16 * (lane >> 4)) * d.N + 64 * nb + (lane & 15) * 4;
#pragma unroll
    for (int i = 0; i < 16; ++i) v[i] = *(const f32x4*)(p + (size_t)i * d.N);
}
DI int map_row_rt(int map, int n) { return map == 1 ? map_row<1>(n) : (map == 2 ? map_row<2>(n) : n); }
DI void p0_store(const P0Desc& d, int lane, const f32x4 (&v)[16], LAS unsigned* scr) {
    const int kb = d.item / d.nblk, nb = d.item - kb * d.nblk, k0 = 64 * kb, n0 = 64 * nb, g = lane >> 4, l15 = lane & 15;
    f32x4 gg[4];
#pragma unroll
    for (int q = 0; q < 4; ++q) gg[q] = d.gain ? *(const f32x4*)(d.gain + k0 + 16 * g + 4 * q) : (f32x4){1.f, 1.f, 1.f, 1.f};
#pragma unroll
    for (int p = 0; p < 8; ++p) {
        const float ga = gg[(2 * p) >> 2][(2 * p) & 3], gb = gg[(2 * p + 1) >> 2][(2 * p + 1) & 3];
#pragma unroll
        for (int e = 0; e < 4; ++e) scr[(4 * l15 + e) * 33 + 8 * g + p] = pk2(v[2 * p][e] * ga, v[2 * p + 1][e] * gb);
    }
    asm volatile("s_waitcnt lgkmcnt(0)" ::: "memory");
    const int c = lane & 7;
#pragma unroll
    for (int j = 0; j < 8; ++j) {
        const int n = (lane >> 3) + 8 * j;
        const LAS unsigned* sp = scr + n * 33 + 4 * c;
        u32x4 o; o.x = sp[0]; o.y = sp[1]; o.z = sp[2]; o.w = sp[3];
        *(u32x4*)(d.WT + (size_t)map_row_rt(d.map, n0 + n) * d.K + k0 + 8 * c) = o;
    }
    asm volatile("s_waitcnt lgkmcnt(0)" ::: "memory");
}

DI void conv_item(LAS unsigned char* lds, int item, const bf16_t* P, const float* cw, const float* cb, const float* lng, const float* lnb, bf16_t* MIX) {
    LAS float* U = (LAS float*)lds;
    const int tid = threadIdx.x, lane = tid & 63, wid = tid >> 6;
    const int tt0 = (item >> 3) * 128, g = item & 7, cbase = g * 128;
    const int bstart = tt0 & ~(SEQ - 1);
    {
        u32x4 vv[5], gv[5];
#pragma unroll
        for (int j = 0; j < 5; ++j) {
            const int id = tid + 512 * j, row = id >> 4, c8 = (id & 15) * 8, tt = tt0 - 30 + row;
            vv[j] = (u32x4){0u, 0u, 0u, 0u}; gv[j] = vv[j];
            if (id < 158 * 16 && tt >= bstart) { vv[j] = *(const u32x4*)(P + (size_t)tt * LDP + cbase + c8); gv[j] = *(const u32x4*)(P + (size_t)tt * LDP + 1024 + cbase + c8); }
        }
#pragma unroll
        for (int j = 0; j < 5; ++j) {
            const int id = tid + 512 * j, row = id >> 4, c8 = (id & 15) * 8;
            const u32x4 v = vv[j], gg = gv[j];
            f32x4 u0, u1;
            u0[0] = bflo(v.x) * sigmoidf_(bflo(gg.x)); u0[1] = bfhi(v.x) * sigmoidf_(bfhi(gg.x));
            u0[2] = bflo(v.y) * sigmoidf_(bflo(gg.y)); u0[3] = bfhi(v.y) * sigmoidf_(bfhi(gg.y));
            u1[0] = bflo(v.z) * sigmoidf_(bflo(gg.z)); u1[1] = bfhi(v.z) * sigmoidf_(bfhi(gg.z));
            u1[2] = bflo(v.w) * sigmoidf_(bflo(gg.w)); u1[3] = bfhi(v.w) * sigmoidf_(bfhi(gg.w));
            if (id < 158 * 16) { *(LAS f32x4*)(U + row * 128 + c8) = u0; *(LAS f32x4*)(U + row * 128 + c8 + 4) = u1; }
        }
    }
    __syncthreads();
    const int c = tid & 127, tq = tid >> 7;
    float y[32];
    {
        float w[31];
#pragma unroll
        for (int k = 0; k < 31; ++k) w[k] = cw[k * 1024 + cbase + c];
        const float bias = cb[cbase + c];
#pragma unroll
        for (int i = 0; i < 32; ++i) y[i] = bias;
        float uw[62];
#pragma unroll
        for (int j = 0; j < 62; ++j) uw[j] = U[(tq * 32 + j) * 128 + c];
#pragma unroll
        for (int i = 0; i < 32; ++i)
#pragma unroll
            for (int k = 0; k < 31; ++k) y[i] += w[k] * uw[i + k];
    }
    __syncthreads();
#pragma unroll
    for (int i = 0; i < 32; ++i) U[(tq * 32 + i) * 128 + c] = y[i];
    __syncthreads();
    {
        const int ts = lane >> 4, cl = lane & 15, ca = 4 * cl, cb2 = 64 + 4 * cl;
        const f32x4 ga = *(const f32x4*)(lng + cbase + ca), gb = *(const f32x4*)(lng + cbase + cb2);
        const f32x4 ba = *(const f32x4*)(lnb + cbase + ca), bb = *(const f32x4*)(lnb + cbase + cb2);
#pragma unroll
        for (int it = 0; it < 4; ++it) {
            const int t = wid * 16 + it * 4 + ts;
            const size_t row = (size_t)(tt0 + t);
            const u32x2 za = *(const u32x2*)(P + row * LDP + 2048 + cbase + ca), zb = *(const u32x2*)(P + row * LDP + 2048 + cbase + cb2);
            f32x4 va = *(LAS f32x4*)(U + t * 128 + ca), vb = *(LAS f32x4*)(U + t * 128 + cb2);
            float sm = ((va[0] + va[1]) + (va[2] + va[3])) + ((vb[0] + vb[1]) + (vb[2] + vb[3]));
            sm += __shfl_xor(sm, 1); sm += __shfl_xor(sm, 2); sm += __shfl_xor(sm, 4); sm += __shfl_xor(sm, 8);
            const float mu = sm * (1.f / 128.f);
            va = va - mu; vb = vb - mu;
            float sq = dot4(va) + dot4(vb);
            sq += __shfl_xor(sq, 1); sq += __shfl_xor(sq, 2); sq += __shfl_xor(sq, 4); sq += __shfl_xor(sq, 8);
            const float rstd = rsqrtf(sq * (1.f / 128.f) + EPS_);
            f32x4 oa = va * rstd * ga + ba, ob = vb * rstd * gb + bb;
            oa[0] = siluf_(oa[0]) * siluf_(bflo(za.x)); oa[1] = siluf_(oa[1]) * siluf_(bfhi(za.x)); oa[2] = siluf_(oa[2]) * siluf_(bflo(za.y)); oa[3] = siluf_(oa[3]) * siluf_(bfhi(za.y));
            ob[0] = siluf_(ob[0]) * siluf_(bflo(zb.x)); ob[1] = siluf_(ob[1]) * siluf_(bfhi(zb.x)); ob[2] = siluf_(ob[2]) * siluf_(bflo(zb.y)); ob[3] = siluf_(ob[3]) * siluf_(bfhi(zb.y));
            *(u32x2*)(MIX + row * DM + cbase + ca) = pack4(oa); *(u32x2*)(MIX + row * DM + cbase + cb2) = pack4(ob);
        }
    }
    __syncthreads();
}

constexpr int KROW = 400, VROW = 320, KBUF_B = 64 * KROW, VBUF_B = 64 * VROW, ATT_STAGE = KBUF_B + VBUF_B;
DI void attn_item(LAS unsigned char* lds, int bh, int qb, const bf16_t* QH, const bf16_t* KN, const bf16_t* KPE, const bf16_t* VT, const bf16_t* P, bf16_t* MIX) {
    const int tid = threadIdx.x, lane = tid & 63, wid = __builtin_amdgcn_readfirstlane(tid >> 6);
    const int rg = wid & 3, kh = wid >> 2, r = lane & 31, h2 = lane >> 5;
    const int b = bh >> 3, h = bh & 7;
    const int q0 = qb * 128;
    const int ntile = 2 * (qb + 1);
    const bf16_t* ksrc[3]; int kdst[3];
#pragma unroll
    for (int j = 0; j < 3; ++j) { const int id = tid + 512 * j, key = id / 24, ch = id - key * 24;
        ksrc[j] = ch < 16 ? KN + ((size_t)bh * SEQ + key) * 128 + ch * 8 : KPE + ((size_t)b * SEQ + key) * 64 + (ch - 16) * 8;
        kdst[j] = key * KROW + ch * 16; }
    const bf16_t* vsrc[2]; int vdst[2];
#pragma unroll
    for (int j = 0; j < 2; ++j) { const int id = tid + 512 * j, key = id >> 4, ch = id & 15;
        vsrc[j] = VT + ((size_t)bh * SEQ + key) * 128 + ch * 8; vdst[j] = key * VROW + ch * 16; }
    const size_t kstep_n = (size_t)64 * 128, kstep_p = (size_t)64 * 64;
    u32x4 kreg[3], vreg[2];
#define ATT_LOAD(t) do { _Pragma("unroll") for (int j = 0; j < 3; ++j) { const int id = tid + 512 * j; const int ch = id % 24; kreg[j] = *(const u32x4*)(ksrc[j] + (size_t)(t) * (ch < 16 ? kstep_n : kstep_p)); } \
        _Pragma("unroll") for (int j = 0; j < 2; ++j) vreg[j] = *(const u32x4*)(vsrc[j] + (size_t)(t) * 8192); } while (0)
#define ATT_STORE(buf) do { LAS unsigned char* kb_ = lds + (buf) * ATT_STAGE; LAS unsigned char* vb_ = kb_ + KBUF_B; \
        _Pragma("unroll") for (int j = 0; j < 3; ++j) *(LAS u32x4*)(kb_ + kdst[j]) = kreg[j]; \
        _Pragma("unroll") for (int j = 0; j < 2; ++j) *(LAS u32x4*)(vb_ + vdst[j]) = vreg[j]; } while (0)
    ATT_LOAD(0);
    bf16x8 Qf[12];
    { const bf16_t* qp = QH + ((size_t)bh * SEQ + q0 + rg * 32 + r) * 192 + 8 * h2;
#pragma unroll
      for (int ks = 0; ks < 12; ++ks) Qf[ks] = *(const bf16x8*)(qp + 16 * ks); }
    ATT_STORE(0);
    ATT_LOAD(1);
    f32x16 O[4];
#pragma unroll
    for (int d = 0; d < 4; ++d)
#pragma unroll
        for (int i = 0; i < 16; ++i) O[d][i] = 0.f;
    const float NEG = -1e30f;
    float mrow = NEG, lrow = 0.f;
    const int qpos = q0 + rg * 32 + r;
    for (int t = 0; t < ntile; ++t) {
        __syncthreads();
        if (t + 1 < ntile) { ATT_STORE((t + 1) & 1); if (t + 2 < ntile) ATT_LOAD(t + 2); }
        LAS unsigned char* kb = lds + (t & 1) * ATT_STAGE; LAS unsigned char* vb = kb + KBUF_B;
        f32x16 S;
#pragma unroll
        for (int i = 0; i < 16; ++i) S[i] = 0.f;
        { const LAS unsigned char* kp = kb + (kh * 32 + r) * KROW + 16 * h2;
          __builtin_amdgcn_s_setprio(1);
#pragma unroll
          for (int ks = 0; ks < 12; ++ks) { const bf16x8 a = *(const LAS bf16x8*)(kp + 32 * ks); S = __builtin_amdgcn_mfma_f32_32x32x16_bf16(a, Qf[ks], S, 0, 0, 0); }
          __builtin_amdgcn_sched_group_barrier(0x100, 4, 0);
#pragma unroll
          for (int i = 0; i < 8; ++i) { __builtin_amdgcn_sched_group_barrier(0x008, 1, 0); __builtin_amdgcn_sched_group_barrier(0x100, 1, 0); }
          __builtin_amdgcn_sched_group_barrier(0x008, 4, 0);
          __builtin_amdgcn_s_setprio(0); }
        const bool diag = (t >= 2 * qb);
        if (diag) {
            const int key0 = t * 64 + kh * 32 + 4 * h2;
#pragma unroll
            for (int i = 0; i < 16; ++i) { const int key = key0 + (i & 3) + 8 * (i >> 2); if (key > qpos) S[i] = NEG; }
        }
        float mx = S[0];
#pragma unroll
        for (int i = 1; i < 16; ++i) mx = fmaxf(mx, S[i]);
        mx = fmaxf(mx, __shfl_xor(mx, 32));
        if (__any(mx > mrow + 8.f)) {
            const float mnew = fmaxf(mrow, mx);
            const float alpha = fexp2(mrow - mnew);
            mrow = mnew; lrow *= alpha;
#pragma unroll
            for (int d = 0; d < 4; ++d)
#pragma unroll
                for (int i = 0; i < 16; ++i) O[d][i] *= alpha;
        }
        float ps = 0.f;
#pragma unroll
        for (int i = 0; i < 16; ++i) { float p = fexp2(S[i] - mrow); if (diag && S[i] == NEG) p = 0.f; S[i] = p; ps += p; }
        lrow += ps;
        bf16x8 pb[2];
#pragma unroll
        for (int s2 = 0; s2 < 2; ++s2) { u32x4 w; w.x = pk2(S[8 * s2 + 0], S[8 * s2 + 1]); w.y = pk2(S[8 * s2 + 2], S[8 * s2 + 3]); w.z = pk2(S[8 * s2 + 4], S[8 * s2 + 5]); w.w = pk2(S[8 * s2 + 6], S[8 * s2 + 7]); pb[s2] = __builtin_bit_cast(bf16x8, w); }
        __builtin_amdgcn_s_setprio(1);
        {
            const int li = lane & 15, gd = (lane >> 4) & 1;
            const LAS unsigned char* vp = vb + (kh * 32 + 4 * h2 + (li >> 2)) * VROW + gd * 32 + (li & 3) * 8;
#pragma unroll
            for (int d = 0; d < 4; ++d)
#pragma unroll
                for (int s2 = 0; s2 < 2; ++s2) {
                    const s16x4 lo = __builtin_amdgcn_ds_read_tr16_b64_v4i16((LAS s16x4*)(vp + (16 * s2) * VROW + 64 * d));
                    const s16x4 hi = __builtin_amdgcn_ds_read_tr16_b64_v4i16((LAS s16x4*)(vp + (16 * s2 + 8) * VROW + 64 * d));
                    const bf16x8 av = __builtin_shufflevector(lo, hi, 0, 1, 2, 3, 4, 5, 6, 7);
                    O[d] = __builtin_amdgcn_mfma_f32_32x32x16_bf16(av, pb[s2], O[d], 0, 0, 0);
                }
        }
        __builtin_amdgcn_s_setprio(0);
    }
    __syncthreads();
#undef ATT_LOAD
#undef ATT_STORE
    lrow += __shfl_xor(lrow, 32);
    LAS float* mb = (LAS float*)lds + (rg * 64 + lane) * 66;
    if (kh == 1) {
#pragma unroll
        for (int d = 0; d < 4; ++d)
#pragma unroll
            for (int i = 0; i < 16; ++i) mb[d * 16 + i] = O[d][i];
        mb[64] = mrow; mb[65] = lrow;
    }
    __syncthreads();
    LAS unsigned char* OBa = lds + 69632;
    if (kh == 0) {
        const float m2 = mb[64], l2 = mb[65];
        const float mn = fmaxf(mrow, m2), w1 = fexp2(mrow - mn), w2 = fexp2(m2 - mn);
        const float inv = frcp(lrow * w1 + l2 * w2);
#pragma unroll
        for (int d = 0; d < 4; ++d)
#pragma unroll
            for (int g4 = 0; g4 < 4; ++g4) {
                const int dd = 32 * d + 8 * g4 + 4 * h2;
                f32x4 o;
#pragma unroll
                for (int e = 0; e < 4; ++e) o[e] = (O[d][4 * g4 + e] * w1 + mb[d * 16 + 4 * g4 + e] * w2) * inv;
                *(LAS u32x2*)(OBa + (rg * 32 + r) * 272 + dd * 2) = pack4(o);
            }
    }
    __syncthreads();
    {
        const bf16_t* zp = P + ((size_t)b * SEQ + q0) * LDP + 4160 + h * 128;
        bf16_t* op = MIX + ((size_t)b * SEQ + q0) * DM + 1024 + h * 128;
#pragma nounroll
        for (int j = 0; j < 4; ++j) {
            const int id = tid + 512 * j, q = id >> 4, c8 = (id & 15) * 8;
            const u32x4 ov = *(const LAS u32x4*)(OBa + q * 272 + c8 * 2);
            const u32x4 z = *(const u32x4*)(zp + (size_t)q * LDP + c8);
            f32x4 o0, o1;
            o0[0] = bflo(ov.x) * siluf_(bflo(z.x)); o0[1] = bfhi(ov.x) * siluf_(bfhi(z.x)); o0[2] = bflo(ov.y) * siluf_(bflo(z.y)); o0[3] = bfhi(ov.y) * siluf_(bfhi(z.y));
            o1[0] = bflo(ov.z) * siluf_(bflo(z.z)); o1[1] = bfhi(ov.z) * siluf_(bfhi(z.z)); o1[2] = bflo(ov.w) * siluf_(bflo(z.w)); o1[3] = bfhi(ov.w) * siluf_(bfhi(z.w));
            *(u32x4*)(op + (size_t)q * DM + c8) = pack8(o0, o1);
        }
    }
    __syncthreads();
}

constexpr int HROW = 272, TROW = 144;
DI bf16_t* ds_item_ptr(unsigned char* ws, unsigned char* ob, int b, int h, int c) { return (bf16_t*)(b == 0 ? ws + WS_DS0 : ob) + ((size_t)(h * 64 + c)) * 16384; }
DI void hg_iv_load(const bf16_t* IVT, int item, u32x4 (&w)[2]) {
    const int tid = threadIdx.x;
#pragma unroll
    for (int j = 0; j < 2; ++j) w[j] = *(const u32x4*)(IVT + (size_t)item * 8192 + (size_t)(tid + 512 * j) * 8);
}
DI void hg_iv_store(LAS unsigned char* VTs, const u32x4 (&wv)[2]) {
    const int tid = threadIdx.x;
#pragma unroll
    for (int j = 0; j < 2; ++j) { const int id = tid + 512 * j, v = id >> 3, ch = id & 7; *(LAS u32x4*)(VTs + v * TROW + ch * 16) = wv[j]; }
}
DI void hgA_load(unsigned char* ws, int item, unsigned (&lf)[16], u32x4 (&ivw)[2]) {
    const int tid = threadIdx.x, b = item >> 10, h = (item >> 6) & 15, c = item & 63, t0 = b * SEQ + c * 64, k = tid & 127, tq = tid >> 7;
    const bf16_t* LOGF = (const bf16_t*)(ws + WS_LOGF);
#pragma unroll
    for (int i = 0; i < 16; ++i) lf[i] = LOGF[(size_t)(t0 + tq * 16 + i) * DM + h * 128 + k];
    hg_iv_load((const bf16_t*)(ws + WS_IV), item, ivw);
}
DI void hgC_load(unsigned char* ws, int item, unsigned (&lf)[16], unsigned (&qv)[16], u32x4 (&ivw)[2]) {
    const int tid = threadIdx.x, b = item >> 10, h = (item >> 6) & 15, c = item & 63, t0 = b * SEQ + c * 64, k = tid & 127, tq = tid >> 7;
    const bf16_t* LOGF = (const bf16_t*)(ws + WS_LOGF);
    const bf16_t* Q2 = (const bf16_t*)(ws + WS_Q2);
#pragma unroll
    for (int i = 0; i < 16; ++i) { const size_t o = (size_t)(t0 + tq * 16 + i) * DM + h * 128 + k; lf[i] = LOGF[o]; qv[i] = Q2[o]; }
    hg_iv_load((const bf16_t*)(ws + WS_IV), item, ivw);
}
DI void hgA_item(LAS unsigned char* lds, unsigned char* ws, unsigned char* ob, int item, const unsigned (&lfr)[16], const u32x4 (&ivw)[2], const float* lbp) {
    const int tid = threadIdx.x, lane = tid & 63, wid = __builtin_amdgcn_readfirstlane(tid >> 6);
    const int b = item >> 10, h = (item >> 6) & 15, c = item & 63;
    const int t0 = b * SEQ + c * 64;
    LAS unsigned char* KTs = lds;
    LAS unsigned char* VTs = lds + 128 * TROW;
    LAS float* tot = (LAS float*)(lds + 2 * 128 * TROW);
    const int k = tid & 127, tq = tid >> 7;
    float lf[16], kk[16];
    { const float lbk = lbp[h * 128 + (tid & 127)];
#pragma unroll
      for (int i = 0; i < 16; ++i) { const float om = (1.f - lbk) * sigmoidf_(-h2f((unsigned short)lfr[i])); kk[i] = om; lf[i] = flog(1.f - om); } }
    float cs[16]; float run = 0.f;
#pragma unroll
    for (int i = 0; i < 16; ++i) { run += lf[i]; cs[i] = run; }
    tot[tq * 128 + k] = run;
    hg_iv_store(VTs, ivw);
    __syncthreads();
    const float t0s = tot[k], t1s = tot[128 + k], t2s = tot[256 + k], t3s = tot[384 + k];
    const float off = (tq > 0 ? t0s : 0.f) + (tq > 1 ? t1s : 0.f) + (tq > 2 ? t2s : 0.f);
    const float blast = (t0s + t1s) + (t2s + t3s);
    {
        float kt[16];
#pragma unroll
        for (int i = 0; i < 16; ++i) kt[i] = kk[i] * fexp(blast - (off + cs[i]));
        u32x4 w0, w1;
        w0.x = pk2(kt[0], kt[1]); w0.y = pk2(kt[2], kt[3]); w0.z = pk2(kt[4], kt[5]); w0.w = pk2(kt[6], kt[7]);
        w1.x = pk2(kt[8], kt[9]); w1.y = pk2(kt[10], kt[11]); w1.z = pk2(kt[12], kt[13]); w1.w = pk2(kt[14], kt[15]);
        *(LAS u32x4*)(KTs + k * TROW + tq * 32) = w0; *(LAS u32x4*)(KTs + k * TROW + tq * 32 + 16) = w1;
    }
    if (tq == 0) ((float*)(ws + WS_DEC))[(size_t)item * 128 + k] = fexp(blast);
    __syncthreads();
    const int vb = wid & 3, kb2 = wid >> 2, r = lane & 31, h2 = lane >> 5;
    f32x16 a0, a1;
#pragma unroll
    for (int i = 0; i < 16; ++i) { a0[i] = 0.f; a1[i] = 0.f; }
#pragma unroll
    for (int ks = 0; ks < 4; ++ks) {
        const bf16x8 av = *(const LAS bf16x8*)(VTs + (32 * vb + r) * TROW + (16 * ks + 8 * h2) * 2);
        const bf16x8 b0 = *(const LAS bf16x8*)(KTs + (64 * kb2 + 2 * r) * TROW + (16 * ks + 8 * h2) * 2);
        const bf16x8 b1 = *(const LAS bf16x8*)(KTs + (64 * kb2 + 2 * r + 1) * TROW + (16 * ks + 8 * h2) * 2);
        a0 = __builtin_amdgcn_mfma_f32_32x32x16_bf16(av, b0, a0, 0, 0, 0);
        a1 = __builtin_amdgcn_mfma_f32_32x32x16_bf16(av, b1, a1, 0, 0, 0);
    }
    bf16_t* D = ds_item_ptr(ws, ob, b, h, c);
#pragma unroll
    for (int i = 0; i < 16; ++i) {
        const int v = 32 * vb + (i & 3) + 8 * (i >> 2) + 4 * h2;
        *(unsigned*)(D + v * 128 + 64 * kb2 + 2 * r) = pk2(a0[i], a1[i]);
    }
    __syncthreads();
}
DI void hgB(unsigned char* ws, unsigned char* ob, int G, int dummy) {
    const float* DEC = (const float*)(ws + WS_DEC);
    for (int gid = blockIdx.x * 512 + threadIdx.x; gid < 32 * 4096; gid += G * 512) {
        const int bh = gid >> 12, e4 = gid & 4095, v = e4 >> 5, k4 = (e4 & 31) * 4;
        const int b = bh >> 4, h = bh & 15;
        bf16_t* D = ds_item_ptr(ws, ob, b, h, 0) + v * 128 + k4;
        const float* dc = DEC + (size_t)bh * 64 * 128 + k4;
        f32x4 S = {0.f, 0.f, 0.f, 0.f};
        for (int cb = 0; cb < 64; cb += 8) {
            u32x2 w[8]; f32x4 d[8];
#pragma unroll
            for (int j = 0; j < 8; ++j) { w[j] = *(const u32x2*)(D + (size_t)(cb + j) * 16384); d[j] = *(const f32x4*)(dc + (cb + j) * 128); }
#pragma unroll
            for (int j = 0; j < 8; ++j) {
                bf16_t* dp = D + (size_t)(cb + j) * 16384;
                if (dummy) dp = (bf16_t*)(ws + WS_DUMMY) + ((((size_t)(h * 64 + cb + j)) * 16384 + v * 128 + k4) & (8 * MiB - 1));
                *(u32x2*)dp = pack4(S);
                const f32x4 ds = {bflo(w[j].x), bfhi(w[j].x), bflo(w[j].y), bfhi(w[j].y)};
                S = d[j] * S + ds;
            }
        }
    }
}
DI void hgC_item(LAS unsigned char* lds, unsigned char* ws, unsigned char* ob, int item, const float* ng, int dummy, const unsigned (&lfr)[16], const unsigned (&qvr)[16], const u32x4 (&ivw)[2], const float* lbp) {
    const int tid = threadIdx.x, lane = tid & 63, wid = __builtin_amdgcn_readfirstlane(tid >> 6);
    const int b = item >> 10, h = (item >> 6) & 15, c = item & 63;
    const int t0 = b * SEQ + c * 64;
    const bf16_t* G2 = (const bf16_t*)(ws + WS_G2);
    bf16_t* MIX2 = (bf16_t*)(ws + WS_Q2);
    if (dummy) MIX2 = (bf16_t*)(ws + WS_DUMMY) - (size_t)(t0 & ~4095) * DM;
    LAS unsigned char* QI = lds;
    LAS unsigned char* QA = lds + 64 * HROW;
    LAS unsigned char* KA = lds + 2 * 64 * HROW;
    LAS unsigned char* VTs = lds + 3 * 64 * HROW;
    LAS float* tot = (LAS float*)(lds + 3 * 64 * HROW + 128 * TROW);
    LAS float* red = tot + 512;
    const int k = tid & 127, tq = tid >> 7;
    const int vb = wid & 3, tb = wid >> 2, r = lane & 31, h2 = lane >> 5;
    LAS unsigned char* SS = lds + 73728;
    u32x4 sreg[4], gz[2];
    { const bf16_t* Sg = ds_item_ptr(ws, ob, b, h, c);
#pragma unroll
      for (int j = 0; j < 4; ++j) sreg[j] = *(const u32x4*)(Sg + (size_t)(tid + 512 * j) * 8);
#pragma unroll
      for (int j = 0; j < 2; ++j) { const int id = tid + 512 * j; gz[j] = *(const u32x4*)(G2 + (size_t)(t0 + (id >> 4)) * DM + h * 128 + (id & 15) * 8); } }
    float lf[16], kk[16];
    { const float lbk = lbp[h * 128 + (tid & 127)];
#pragma unroll
      for (int i = 0; i < 16; ++i) { const float om = (1.f - lbk) * sigmoidf_(-h2f((unsigned short)lfr[i])); kk[i] = om; lf[i] = flog(1.f - om); } }
    float qv[16];
#pragma unroll
    for (int i = 0; i < 16; ++i) qv[i] = bf2f((unsigned short)qvr[i]);
    float cs[16]; float run = 0.f;
#pragma unroll
    for (int i = 0; i < 16; ++i) { run += lf[i]; cs[i] = run; }
    tot[tq * 128 + k] = run;
    hg_iv_store(VTs, ivw);
#pragma unroll
    for (int j = 0; j < 4; ++j) { const int id = tid + 512 * j; *(LAS u32x4*)(SS + (id >> 4) * HROW + (id & 15) * 16) = sreg[j]; }
    __syncthreads();
    {
        const float t0s = tot[k], t1s = tot[128 + k], t2s = tot[256 + k];
        const float off = (tq > 0 ? t0s : 0.f) + (tq > 1 ? t1s : 0.f) + (tq > 2 ? t2s : 0.f);
        const float bref = t0s + t1s;
#pragma unroll
        for (int i = 0; i < 16; ++i) {
            const float bb = off + cs[i];
            const int t = tq * 16 + i;
            const float qi = qv[i] * fexp(bb);
            const float qa = qv[i] * fexp(fminf(bb - bref, 80.f));
            const float ka = kk[i] * fexp(fminf(bref - bb, 80.f));
            *(LAS bf16_t*)(QI + t * HROW + k * 2) = (bf16_t)(pk2(qi, 0.f) & 0xffff);
            *(LAS bf16_t*)(QA + t * HROW + k * 2) = (bf16_t)(pk2(qa, 0.f) & 0xffff);
            *(LAS bf16_t*)(KA + t * HROW + k * 2) = (bf16_t)(pk2(ka, 0.f) & 0xffff);
        }
    }
    __syncthreads();
    f32x16 acc;
#pragma unroll
    for (int i = 0; i < 16; ++i) acc[i] = 0.f;
    {
        const LAS unsigned char* qp = QI + (32 * tb + r) * HROW + 16 * h2;
#pragma unroll
        for (int ks = 0; ks < 8; ++ks) {
            const bf16x8 bq = *(const LAS bf16x8*)(qp + 32 * ks);
            const bf16x8 sa = *(const LAS bf16x8*)(SS + (32 * vb + r) * HROW + 16 * h2 + 32 * ks);
            acc = __builtin_amdgcn_mfma_f32_32x32x16_bf16(sa, bq, acc, 0, 0, 0);
        }
        __builtin_amdgcn_sched_group_barrier(0x100, 4, 0);
#pragma unroll
        for (int i = 0; i < 6; ++i) { __builtin_amdgcn_sched_group_barrier(0x008, 1, 0); __builtin_amdgcn_sched_group_barrier(0x100, 2, 0); }
        __builtin_amdgcn_sched_group_barrier(0x008, 2, 0);
    }
    for (int sb = 0; sb <= tb; ++sb) {
        f32x16 AT;
#pragma unroll
        for (int i = 0; i < 16; ++i) AT[i] = 0.f;
        const LAS unsigned char* kp = KA + (32 * sb + r) * HROW + 16 * h2;
        const LAS unsigned char* qp = QA + (32 * tb + r) * HROW + 16 * h2;
#pragma unroll
        for (int ks = 0; ks < 8; ++ks) {
            const bf16x8 a = *(const LAS bf16x8*)(kp + 32 * ks);
            const bf16x8 bq = *(const LAS bf16x8*)(qp + 32 * ks);
            AT = __builtin_amdgcn_mfma_f32_32x32x16_bf16(a, bq, AT, 0, 0, 0);
        }
        __builtin_amdgcn_sched_group_barrier(0x100, 4, 0);
#pragma unroll
        for (int i = 0; i < 6; ++i) { __builtin_amdgcn_sched_group_barrier(0x008, 1, 0); __builtin_amdgcn_sched_group_barrier(0x100, 2, 0); }
        __builtin_amdgcn_sched_group_barrier(0x008, 2, 0);
        if (sb == tb) {
#pragma unroll
            for (int i = 0; i < 16; ++i) { const int s = (i & 3) + 8 * (i >> 2) + 4 * h2; if (s > r) AT[i] = 0.f; }
        }
#pragma unroll
        for (int s2 = 0; s2 < 2; ++s2) {
            u32x4 w; w.x = pk2(AT[8 * s2 + 0], AT[8 * s2 + 1]); w.y = pk2(AT[8 * s2 + 2], AT[8 * s2 + 3]); w.z = pk2(AT[8 * s2 + 4], AT[8 * s2 + 5]); w.w = pk2(AT[8 * s2 + 6], AT[8 * s2 + 7]);
            const LAS unsigned char* vp = VTs + (32 * vb + r) * TROW + (32 * sb + 16 * s2 + 4 * h2) * 2;
            const u32x2 lo = *(const LAS u32x2*)vp, hi = *(const LAS u32x2*)(vp + 16);
            const u32x4 aw = {lo.x, lo.y, hi.x, hi.y};
            acc = __builtin_amdgcn_mfma_f32_32x32x16_bf16(__builtin_bit_cast(bf16x8, aw), __builtin_bit_cast(bf16x8, w), acc, 0, 0, 0);
        }
    }
    float ss = 0.f;
#pragma unroll
    for (int i = 0; i < 16; ++i) ss += acc[i] * acc[i];
    ss += __shfl_xor(ss, 32);
    if (h2 == 0) red[vb * 64 + tb * 32 + r] = ss;
    __syncthreads();
    {
        const int t = tb * 32 + r;
        const float tots = (red[t] + red[64 + t]) + (red[128 + t] + red[192 + t]);
        const float rs = rsqrtf(tots * (1.f / 128.f) + EPS_);
        LAS unsigned char* OB = QI;
#pragma unroll
        for (int g4 = 0; g4 < 4; ++g4) {
            const int v0 = 32 * vb + 8 * g4 + 4 * h2;
            const f32x4 o = {acc[4 * g4 + 0] * rs, acc[4 * g4 + 1] * rs, acc[4 * g4 + 2] * rs, acc[4 * g4 + 3] * rs};
            *(LAS u32x2*)(OB + t * HROW + v0 * 2) = pack4(o);
        }
    }
    __syncthreads();
#pragma unroll
    for (int j = 0; j < 2; ++j) {
        const int id = tid + 512 * j, t = id >> 4, c8 = (id & 15) * 8;
        const u32x4 ov = *(const LAS u32x4*)(QI + t * HROW + c8 * 2);
        const f32x4 n0 = *(const f32x4*)(ng + c8), n1 = *(const f32x4*)(ng + c8 + 4);
        const u32x4 z = gz[j];
        f32x4 o0, o1;
        o0[0] = bflo(ov.x) * n0[0] * siluf_(bflo(z.x)); o0[1] = bfhi(ov.x) * n0[1] * siluf_(bfhi(z.x));
        o0[2] = bflo(ov.y) * n0[2] * siluf_(bflo(z.y)); o0[3] = bfhi(ov.y) * n0[3] * siluf_(bfhi(z.y));
        o1[0] = bflo(ov.z) * n1[0] * siluf_(bflo(z.z)); o1[1] = bfhi(ov.z) * n1[1] * siluf_(bfhi(z.z));
        o1[2] = bflo(ov.w) * n1[2] * siluf_(bflo(z.w)); o1[3] = bfhi(ov.w) * n1[3] * siluf_(bfhi(z.w));
        *(u32x4*)(MIX2 + (size_t)(t0 + t) * DM + h * 128 + c8) = pack8(o0, o1);
    }
    __syncthreads();
}

constexpr int LDS_BYTES = 147456;
constexpr int NPH = 12;

__global__ void __launch_bounds__(512, 2) fwd_kernel(Args a) {
    extern __shared__ __attribute__((aligned(16))) unsigned char lds_raw[];
    LAS unsigned char* lds = (LAS unsigned char*)lds_raw;
    cg::grid_group grid = cg::this_grid();
    const int tid = threadIdx.x, lane = tid & 63, wave = __builtin_amdgcn_readfirstlane(tid >> 6);
    const int G = gridDim.x, bx = blockIdx.x;
    const int vcu = (G % 8 == 0) ? (bx % 8) * (G / 8) + bx / 8 : bx;
    unsigned char* ws = a.ws;
    const int lo = a.ph_lo, hi = a.ph_hi;
    if (a.flags & 128) grid.sync();
    volatile LAS unsigned* bst = (volatile LAS unsigned*)(lds + 131072 + 256);
    if (tid < 4) bst[tid] = 0u;
    __syncthreads();
    XcdBarrier bar = xcd_barrier_post((unsigned*)(ws + WS_BAR) + a.li * XCD_BAR_WORDS, bst);
#define IN(k) (lo <= (k) && (k) < hi)
#define SEAM(k) do { if (IN(k) && IN((k) + 1)) xcd_barrier(bar); } while (0)
    const float* x = a.in[0];
    float* rs0 = (float*)(ws + WS_RS0);
    float* lbv = (float*)(ws + WS_LB);
    float* ssq = (float*)(ws + WS_SSQ);
    float* ssq1 = (float*)(ws + WS_SSQ1);
    float* ropec = (float*)(ws + WS_ROPEC);
    float* ropes = (float*)(ws + WS_ROPES);
    bf16_t* PB = (bf16_t*)(ws + WS_PBUF);
    bf16_t* MIX = (bf16_t*)a.out;

    if (IN(0)) {
        LAS unsigned* scr = (LAS unsigned*)(lds + wave * 16384);
        const int gw = vcu * 8 + wave, NGW = G * 8;
        constexpr int I0 = 32 * 81, I1 = 8 * 24, I2 = 8 * 32;
        constexpr int NIT = I0 + I1 + I2;
#define P0_DESC(it_, d_) do { int r_ = (it_); \
            if (r_ < I0) { d_ = P0Desc{a.in[2], a.in[1], (bf16_t*)(ws + WS_WEVIN), 2048, EVIN, 81, 1, r_}; } else { r_ -= I0; \
            if (r_ < I1) { d_ = P0Desc{a.in[8], a.in[7], (bf16_t*)(ws + WS_WUQ), 512, 1536, 24, 2, r_}; } else { r_ -= I1; \
            d_ = P0Desc{a.in[10], a.in[9], (bf16_t*)(ws + WS_WUKV), 512, 2048, 32, 0, r_}; } } } while (0)
        {
            int it = gw;
            f32x4 va[16]; P0Desc da;
            if (it < NIT) { P0_DESC(it, da); p0_load(da, lane, va); }
            while (it < NIT) {
                const int nx = it + NGW;
                f32x4 vb[16]; P0Desc db = da;
                if (nx < NIT) { P0_DESC(nx, db); p0_load(db, lane, vb); }
                p0_store(da, lane, va, scr);
#pragma unroll
                for (int i = 0; i < 16; ++i) va[i] = vb[i];
                da = db; it = nx;
            }
        }
#undef P0_DESC
        { u32x4* z = (u32x4*)(ws + WS_WEVIN + (size_t)EVIN * 2048 * 2); const int nz = (EVIN_PAD - EVIN) * 2048 * 2 / 16;
          for (int i = bx * 512 + tid; i < nz; i += G * 512) z[i] = (u32x4){0u, 0u, 0u, 0u}; }
        bf16_t* XB = (bf16_t*)(ws + WS_XB);
        for (int m = gw; m < T_; m += NGW) {
            const f32x4* xr = (const f32x4*)(x + (size_t)m * DM) + lane;
            f32x4 v[8]; float s = 0.f;
#pragma unroll
            for (int j = 0; j < 8; ++j) { v[j] = xr[64 * j]; s += dot4(v[j]); }
            s = wave_sum(s);
            if (lane == 0) rs0[m] = rsqrtf(s * (1.f / 2048.f) + EPS_);
            u32x2* o8 = (u32x2*)(XB + (size_t)m * DM) + lane;
#pragma unroll
            for (int j = 0; j < 8; ++j) o8[64 * j] = pack4(v[j]);
        }
        for (int i = bx * 512 + tid; i < 2048; i += G * 512) { const float l0 = a.in[14][i], l1 = a.in[14][2048 + i]; lbv[i] = 1.f / (1.f + expf(l0 - l1)); }
        for (int i = bx * 512 + tid; i < SEQ * 32; i += G * 512) {
            const int pos = i >> 5, j = i & 31;
            const float inv = 1.0f / powf(10000.0f, (float)(2 * j) / 64.0f);
            const float ang = (float)pos * inv;
            ropec[i] = cosf(ang); ropes[i] = sinf(ang);
        }
    }
    SEAM(0);
    if (IN(1)) {
        pg8::Gemm g{(const bf16_t*)(ws + WS_XB), (const bf16_t*)(ws + WS_WEVIN), T_, EVIN_PAD, 2048, 2048, 2048};
        pg8::StaticOrder S; S.init(T_, EVIN_PAD, G, bx);
        {
            const int nunits = 32 * (EVIN_PAD / 256);
            const int nfull = nunits % G;
            const int nw = (nfull == 0) ? G : (G - nfull);
            const int wk = (nfull == 0) ? bx : (bx - nfull);
            if (wk >= 0) {
                LAS unsigned* scr = (LAS unsigned*)(lds + wave * 16384);
                constexpr int I3 = 32 * 32, I4 = 32 * 128, NIT = I3 + I4;
#define P1_DESC(it_, d_) do { int r_ = (it_); \
                if (r_ < I3) { d_ = P0Desc{a.in[11], nullptr, (bf16_t*)(ws + WS_WEVOUT), 2048, 2048, 32, 0, r_}; } else { r_ -= I3; \
                d_ = P0Desc{a.in[13], a.in[12], (bf16_t*)(ws + WS_WODIN), 2048, 8192, 128, 0, r_}; } } while (0)
                int it = wk * 8 + wave; const int NGW2 = nw * 8;
                f32x4 va[16]; P0Desc da;
                if (it < NIT) { P1_DESC(it, da); p0_load(da, lane, va); }
                while (it < NIT) {
                    const int nx = it + NGW2;
                    f32x4 vb[16]; P0Desc db = da;
                    if (nx < NIT) { P1_DESC(nx, db); p0_load(db, lane, vb); }
                    p0_store(da, lane, va, scr);
#pragma unroll
                    for (int i = 0; i < 16; ++i) va[i] = vb[i];
                    da = db; it = nx;
                }
#undef P1_DESC
            }
        }
        __syncthreads();
        EpiP1 E{PB, rs0, (bf16_t*)(ws + WS_KPE), ssq, ropec, ropes};
        pg8::gemm_phase<EpiP1, pg8::StaticOrder>(lds, g, S, E);
    }
    SEAM(1);
    if (IN(2)) {
        { pg8::Gemm g{PB + 3584, (const bf16_t*)(ws + WS_WUKV), T_, 2048, 512, LDP, 512};
          pg8::StaticOrder S; S.init(T_, 2048, G, bx);
          EpiKV E{(bf16_t*)(ws + WS_KN), (bf16_t*)(ws + WS_VT), ssq};
          pg8::gemm_phase<EpiKV, pg8::StaticOrder>(lds, g, S, E); }
        { pg8::Gemm g{PB + 3072, (const bf16_t*)(ws + WS_WUQ), T_, 1536, 512, LDP, 512};
          pg8::StaticOrder S; S.init(T_, 1536, G, (bx + 64) % G);
          EpiQ E{(bf16_t*)(ws + WS_QH), ssq};
          pg8::gemm_phase<EpiQ, pg8::StaticOrder>(lds, g, S, E); }
        { const int cq = (bx + 64) % G, nidle = G - 192;
          if (nidle >= 32 && cq >= 192) {
              LAS unsigned* scr = (LAS unsigned*)(lds + wave * 16384);
              for (int it = (cq - 192) * 8 + wave; it < 32 * 32; it += nidle * 8) {
                  f32x4 va[16]; P0Desc da = P0Desc{a.in[16], nullptr, (bf16_t*)(ws + WS_WODOUT), 2048, 2048, 32, 0, it};
                  p0_load(da, lane, va); p0_store(da, lane, va, scr);
              }
          } }
    }
    if (IN(3)) {
        __syncthreads();
        for (int it = bx; it < 512; it += G) conv_item(lds, it, PB, a.in[3], a.in[4], a.in[5], a.in[6], MIX);
        LAS unsigned* scr = (LAS unsigned*)(lds + wave * 16384);
        if (G - 192 < 32) for (int it = bx * 8 + wave; it < 32 * 32; it += G * 8) {
            f32x4 va[16]; P0Desc da = P0Desc{a.in[16], nullptr, (bf16_t*)(ws + WS_WODOUT), 2048, 2048, 32, 0, it};
            p0_load(da, lane, va); p0_store(da, lane, va, scr);
        }
    }
    SEAM(3);
    if (IN(4)) {
        for (int p = vcu; p < 256; p += G) {
            const int bh = p >> 4, i = p & 15;
            attn_item(lds, bh, 31 - i, (const bf16_t*)(ws + WS_QH), (const bf16_t*)(ws + WS_KN), (const bf16_t*)(ws + WS_KPE), (const bf16_t*)(ws + WS_VT), PB, MIX);
            attn_item(lds, bh, i, (const bf16_t*)(ws + WS_QH), (const bf16_t*)(ws + WS_KN), (const bf16_t*)(ws + WS_KPE), (const bf16_t*)(ws + WS_VT), PB, MIX);
        }
    }
    SEAM(4);
    if (IN(5)) {
        pg8::Gemm g{MIX, (const bf16_t*)(ws + WS_WEVOUT), T_, 2048, 2048, 2048, 2048};
        pg8::StaticOrder S; S.init(T_, 2048, G, bx);
        EpiRes1 E{(const bf16_t*)(ws + WS_XB), (bf16_t*)(ws + WS_X1B), ssq1};
        pg8::gemm_phase<EpiRes1, pg8::StaticOrder>(lds, g, S, E);
    }
    SEAM(5);
    if (IN(6)) {
        pg8::Gemm g{(const bf16_t*)(ws + WS_X1B), (const bf16_t*)(ws + WS_WODIN), T_, 8192, 2048, 2048, 2048};
        pg8::StaticOrder S; S.init(T_, 8192, G, bx);
        EpiHg E{ws, (bf16_t*)(ws + WS_LOGF), ssq1, lbv};
        pg8::gemm_phase<EpiHg, pg8::StaticOrder>(lds, g, S, E);
    }
    SEAM(6);
    if (IN(7)) {
        __syncthreads();
        int it = bx; unsigned lfa[16]; u32x4 iva[2];
        if (it < 2048) hgA_load(ws, it, lfa, iva);
        while (it < 2048) {
            const int nx = it + G; unsigned lfb[16]; u32x4 ivb[2];
#pragma unroll
            for (int i = 0; i < 16; ++i) lfb[i] = 0u;
            ivb[0] = iva[0]; ivb[1] = iva[1];
            if (nx < 2048) hgA_load(ws, nx, lfb, ivb);
            hgA_item(lds, ws, (unsigned char*)a.out, it, lfa, iva, lbv);
#pragma unroll
            for (int i = 0; i < 16; ++i) lfa[i] = lfb[i];
            iva[0] = ivb[0]; iva[1] = ivb[1]; it = nx;
        }
    }
    SEAM(7);
    if (IN(8)) hgB(ws, (unsigned char*)a.out, G, a.flags & 1);
    SEAM(8);
    if (IN(9)) {
        __syncthreads();
        int it = bx; unsigned lfa[16], qva[16]; u32x4 iva[2];
        if (it < 2048) hgC_load(ws, it, lfa, qva, iva);
        while (it < 2048) {
            const int nx = it + G; unsigned lfb[16], qvb[16]; u32x4 ivb[2];
#pragma unroll
            for (int i = 0; i < 16; ++i) { lfb[i] = 0u; qvb[i] = 0u; }
            ivb[0] = iva[0]; ivb[1] = iva[1];
            if (nx < 2048) hgC_load(ws, nx, lfb, qvb, ivb);
            hgC_item(lds, ws, (unsigned char*)a.out, it, a.in[15], a.flags & 2, lfa, qva, iva, lbv);
#pragma unroll
            for (int i = 0; i < 16; ++i) { lfa[i] = lfb[i]; qva[i] = qvb[i]; }
            iva[0] = ivb[0]; iva[1] = ivb[1]; it = nx;
        }
    }
    SEAM(9);
    if (IN(10)) {
        pg8::Gemm g{(const bf16_t*)(ws + WS_Q2), (const bf16_t*)(ws + WS_WODOUT), T_, 2048, 2048, 2048, 2048};
        pg8::StaticOrder S; S.init(T_, 2048, G, bx);
        if (G == 256) {
            EpiRes2N E{(const bf16_t*)(ws + WS_X1B), a.out, a.in[17], ssq, (unsigned*)(ws + WS_PCNT)};
            pg8::gemm_phase<EpiRes2N, pg8::StaticOrder>(lds, g, S, E);
        } else {
            EpiRes2 E{(const bf16_t*)(ws + WS_X1B), a.out};
            pg8::gemm_phase<EpiRes2, pg8::StaticOrder>(lds, g, S, E);
        }
    }
    if (G != 256) SEAM(10);
    if (IN(11) && G != 256) {
        const int gw = bx * 8 + wave, NGW = G * 8;
        const float* fg = a.in[17];
        for (int m = gw; m < T_; m += NGW) {
            f32x4* xr = (f32x4*)(a.out + (size_t)m * DM) + lane;
            f32x4 v[8]; float s = 0.f;
#pragma unroll
            for (int j = 0; j < 8; ++j) { v[j] = xr[64 * j]; s += dot4(v[j]); }
            s = wave_sum(s);
            const float rs = rsqrtf(s * (1.f / 2048.f) + EPS_);
#pragma unroll
            for (int j = 0; j < 8; ++j) { const f32x4 gg = *((const f32x4*)fg + lane + 64 * j); xr[64 * j] = v[j] * rs * gg; }
        }
    }
#undef IN
#undef SEAM
}


extern "C" void kernel_launch(void* const* d_in, const int* in_sizes, int n_in, void* d_out, int out_size, void* d_ws, size_t ws_size, hipStream_t stream) {
    static int grid = 0;
    if (grid == 0) {
        if (n_in != 18 || out_size != T_ * DM || ws_size < WS_NEED) { fprintf(stderr, "kernel_launch: unexpected shapes (n_in %d out %d ws %zu, need %zu)\n", n_in, out_size, ws_size, (size_t)WS_NEED); grid = -1; return; }
        int dev = 0, cus = 0, per_cu = 0;
        (void)hipGetDevice(&dev);
        (void)hipDeviceGetAttribute(&cus, hipDeviceAttributeMultiprocessorCount, dev);
        if (hipFuncSetAttribute((const void*)fwd_kernel, hipFuncAttributeMaxDynamicSharedMemorySize, LDS_BYTES) != hipSuccess) { fprintf(stderr, "kernel_launch: hipFuncSetAttribute failed\n"); grid = -1; return; }
        if (hipOccupancyMaxActiveBlocksPerMultiprocessor(&per_cu, (const void*)fwd_kernel, 512, LDS_BYTES) != hipSuccess || per_cu < 1) { fprintf(stderr, "kernel_launch: occupancy query says %d\n", per_cu); per_cu = 1; }
        (void)hipGetLastError();
        grid = cus * per_cu;
    }
    if (grid < 0) return;
    Args a{};
    for (int i = 0; i < 18; ++i) a.in[i] = (const float*)d_in[i];
    a.out = (float*)d_out; a.ws = (unsigned char*)d_ws;
#ifndef PROBE_PH
#define PROBE_PH -1
#endif
    if (hipMemsetAsync((char*)d_ws + WS_BAR, 0, 2 * XCD_BAR_WORDS * 4 + 32 * 64 * 4, stream) != hipSuccess) { fprintf(stderr, "kernel_launch: memset failed\n"); return; }
    const int nl = PROBE_PH >= 0 ? 2 : 1;
    const int los[2] = {0, PROBE_PH}, his[2] = {PROBE_PH >= 0 ? PROBE_PH + 1 : NPH, NPH};
    for (int li = 0; li < nl; ++li) {
        a.ph_lo = los[li]; a.ph_hi = his[li]; a.li = li; a.flags = (nl == 2 && li == 0) ? ((PROBE_PH == 8 ? 1 : 0) | (PROBE_PH == 9 ? 2 : 0)) : 0;
        void* args[] = {&a};
        hipError_t e = hipLaunchCooperativeKernel((const void*)fwd_kernel, dim3(grid), dim3(512), args, LDS_BYTES, stream);
        if (e != hipSuccess) fprintf(stderr, "cooperative launch failed: %s (grid %d)\n", hipGetErrorString(e), grid);
    }
}
```
